# Optimizing an MI355X kernel written in HIP

```python
import jax, jax.numpy as jnp
from jax import lax
import numpy as np

D_MODEL = 1024
BATCH = 8
SEQ = 4096
DEPTH = 2

CHUNK = 64
MIX_WIDTH = D_MODEL
GM_WIDTH = MIX_WIDTH // 2
GM_BLOCK = 128
GM_GROUPS = 4
GM_CH = GM_WIDTH // GM_GROUPS
MLA_HEADS = 8
QK_NOPE = 64
QK_ROPE = 32
QK_DIM = QK_NOPE + QK_ROPE
V_DIM = 64
MLA_WIDTH = MLA_HEADS * V_DIM
Q_LORA = 384
KV_LORA = 256
ROPE_THETA = 10000.0
Q_BLOCK = 128
IN_COLS = 2 * GM_WIDTH + Q_LORA + KV_LORA + QK_ROPE
N_EXPERTS = 64
TOP_K = 8
N_GROUPS = 8
TOPK_GROUPS = 4
EXPERT_FF = 256
SHARED_FF = 256
ROUTED_SCALE = 2.5
EXPERT_BLOCK = 8
EPS = 1e-6

kernel_name = "hybrid_gmlp_mla_moe_adaln_trunk"


def rms_norm(x, g):
    xf = x.astype(jnp.float32)
    y = xf * lax.rsqrt(jnp.mean(xf * xf, axis=-1, keepdims=True) + EPS)
    return (y * g.astype(jnp.float32)).astype(x.dtype)


def layer_norm(x, g, b):
    xf = x.astype(jnp.float32)
    mu = jnp.mean(xf, axis=-1, keepdims=True)
    xc = xf - mu
    y = xc * lax.rsqrt(jnp.mean(xc * xc, axis=-1, keepdims=True) + EPS)
    return (y * g.astype(jnp.float32) + b.astype(jnp.float32)).astype(x.dtype)


def rope_tables(positions):
    inv_freq = 1.0 / (ROPE_THETA ** (jnp.arange(0, QK_ROPE, 2, dtype=jnp.float32) / QK_ROPE))
    ang = positions.astype(jnp.float32)[..., None] * inv_freq
    return jnp.cos(ang)[:, :, None, :], jnp.sin(ang)[:, :, None, :]


def apply_rope(x, cos, sin):
    xf = x.astype(jnp.float32)
    x1, x2 = jnp.split(xf, 2, axis=-1)
    return jnp.concatenate([x1 * cos - x2 * sin, x1 * sin + x2 * cos], axis=-1).astype(x.dtype)


def gmlp_mixer(uv, ln_g, ln_b, w_s, b_s):
    B, S, _ = uv.shape
    uv = jax.nn.gelu(uv, approximate=False)
    u, v = jnp.split(uv, 2, axis=-1)
    v = v.reshape(B, S // GM_BLOCK, GM_BLOCK, GM_GROUPS, GM_CH)
    v = layer_norm(v, ln_g, ln_b)
    mask = jnp.tril(jnp.ones((GM_BLOCK, GM_BLOCK), dtype=w_s.dtype))
    ws = w_s * mask
    gate = jnp.einsum('gts,bnsgc->bntgc', ws, v) + b_s.T[:, :, None]
    return u * gate.reshape(B, S, GM_WIDTH)


def chunk_causal_attention(q, k, v):
    B, S, H, Dq = q.shape
    nb = S // Q_BLOCK
    scale = QK_DIM ** -0.5
    k_chunk = jnp.arange(S) // CHUNK
    qb = jnp.moveaxis(q.reshape(B, nb, Q_BLOCK, H, Dq), 1, 0)

    def block(args):
        q_blk, i = args
        q_chunk = (i * Q_BLOCK + jnp.arange(Q_BLOCK)) // CHUNK
        s = jnp.einsum('bqhd,bkhd->bhqk', q_blk, k).astype(jnp.float32) * scale
        allowed = k_chunk[None, :] <= q_chunk[:, None]
        s = jnp.where(allowed, s, -jnp.inf)
        p = jax.nn.softmax(s, axis=-1).astype(v.dtype)
        return jnp.einsum('bhqk,bkhd->bqhd', p, v)

    out = lax.map(block, (qb, jnp.arange(nb)))
    return jnp.moveaxis(out, 0, 1).reshape(B, S, H, v.shape[-1])


def mla_mixer(q_lat, kv_lat, k_pe, cos, sin, q_a_g, w_q_up, kv_a_g, w_kv_up, q_norm_g, k_norm_g):
    B, S, _ = q_lat.shape
    q = (rms_norm(q_lat, q_a_g) @ w_q_up).reshape(B, S, MLA_HEADS, QK_DIM)
    kv = (rms_norm(kv_lat, kv_a_g) @ w_kv_up).reshape(B, S, MLA_HEADS, QK_NOPE + V_DIM)
    k_nope, v = kv[..., :QK_NOPE], kv[..., QK_NOPE:]
    k_pe_h = jnp.broadcast_to(k_pe[:, :, None, :], (B, S, MLA_HEADS, QK_ROPE))
    k = jnp.concatenate([k_nope, k_pe_h], axis=-1)
    q = rms_norm(q, q_norm_g)
    k = rms_norm(k, k_norm_g)
    q = jnp.concatenate([q[..., :QK_NOPE], apply_rope(q[..., QK_NOPE:], cos, sin)], axis=-1)
    k = jnp.concatenate([k[..., :QK_NOPE], apply_rope(k[..., QK_NOPE:], cos, sin)], axis=-1)
    out = chunk_causal_attention(q, k, v)
    return out.reshape(B, S, MLA_WIDTH)


def moe_ffn(h, w_router, router_bias, w_gate, w_up, w_down, ws_gate, ws_up, ws_down):
    B, S, D = h.shape
    t = h.reshape(-1, D)
    n_tok = t.shape[0]
    scores = jax.nn.sigmoid((t @ w_router).astype(jnp.float32))
    biased = scores + router_bias.astype(jnp.float32)
    grp = biased.reshape(n_tok, N_GROUPS, N_EXPERTS // N_GROUPS)
    grp_score = jnp.sum(lax.top_k(grp, 2)[0], axis=-1)
    _, gidx = lax.top_k(grp_score, TOPK_GROUPS)
    gmask = jnp.sum(jax.nn.one_hot(gidx, N_GROUPS, dtype=jnp.float32), axis=-2)
    emask = jnp.repeat(gmask, N_EXPERTS // N_GROUPS, axis=-1) > 0
    _, eidx = lax.top_k(jnp.where(emask, biased, -jnp.inf), TOP_K)
    w = jnp.take_along_axis(scores, eidx, axis=-1)
    w = w / jnp.sum(w, axis=-1, keepdims=True) * ROUTED_SCALE
    combine = jnp.sum(jax.nn.one_hot(eidx, N_EXPERTS, dtype=jnp.float32) * w[..., None], axis=1)
    combine = combine.astype(t.dtype)
    routed = jnp.zeros_like(t)
    for e0 in range(0, N_EXPERTS, EXPERT_BLOCK):
        sl = slice(e0, e0 + EXPERT_BLOCK)
        hg = jnp.einsum('nd,edf->nef', t, w_gate[sl])
        hu = jnp.einsum('nd,edf->nef', t, w_up[sl])
        hw = jax.nn.silu(hg) * hu * combine[:, sl, None]
        routed = routed + jnp.einsum('nef,efd->nd', hw, w_down[sl])
    shared = (jax.nn.silu(t @ ws_gate) * (t @ ws_up)) @ ws_down
    return (routed + shared).reshape(B, S, D)


def setup_inputs(seed: int = 0) -> dict:
    key = jax.random.key(seed)
    ks = jax.random.split(key, 32)
    L, D = DEPTH, D_MODEL

    def nrm(k, shape, scale):
        return jax.random.normal(k, shape, dtype=jnp.float32) * scale

    def gain(k, shape):
        return 1.0 + 0.02 * jax.random.normal(k, shape, dtype=jnp.float32)

    offset = jax.random.randint(ks[2], (BATCH, 1), 0, 256, dtype=jnp.int32) * CHUNK
    positions = offset + jnp.arange(SEQ, dtype=jnp.int32)[None, :]
    return {
        "x": nrm(ks[0], (BATCH, SEQ, D), 1.0),
        "c": nrm(ks[1], (BATCH, D), 1.0),
        "positions": positions,
        "norm_mix_g": gain(ks[3], (L, D)),
        "norm_ffn_g": gain(ks[4], (L, D)),
        "w_ada": nrm(ks[5], (L, D, 6 * D), 0.5 * D ** -0.5),
        "b_ada": nrm(ks[6], (L, 6 * D), 0.02),
        "w_in": nrm(ks[7], (L, D, IN_COLS), D ** -0.5),
        "gm_ln_g": gain(ks[8], (L, GM_GROUPS, GM_CH)),
        "gm_ln_b": nrm(ks[9], (L, GM_GROUPS, GM_CH), 0.02),
        "gm_ws": nrm(ks[10], (L, GM_GROUPS, GM_BLOCK, GM_BLOCK), GM_BLOCK ** -0.5),
        "gm_bs": gain(ks[11], (L, GM_GROUPS, GM_BLOCK)),
        "q_a_g": gain(ks[12], (L, Q_LORA)),
        "w_q_up": nrm(ks[13], (L, Q_LORA, MLA_HEADS * QK_DIM), Q_LORA ** -0.5),
        "kv_a_g": gain(ks[14], (L, KV_LORA)),
        "w_kv_up": nrm(ks[15], (L, KV_LORA, MLA_HEADS * (QK_NOPE + V_DIM)), KV_LORA ** -0.5),
        "q_norm_g": gain(ks[16], (L, QK_DIM)),
        "k_norm_g": gain(ks[17], (L, QK_DIM)),
        "out_norm_g": gain(ks[18], (L, MIX_WIDTH)),
        "w_out": nrm(ks[19], (L, MIX_WIDTH, D), MIX_WIDTH ** -0.5),
        "w_router": nrm(ks[20], (L, D, N_EXPERTS), D ** -0.5),
        "router_bias": nrm(ks[21], (L, N_EXPERTS), 0.01),
        "w_exp_gate": nrm(ks[22], (L, N_EXPERTS, D, EXPERT_FF), D ** -0.5),
        "w_exp_up": nrm(ks[23], (L, N_EXPERTS, D, EXPERT_FF), D ** -0.5),
        "w_exp_down": nrm(ks[24], (L, N_EXPERTS, EXPERT_FF, D), EXPERT_FF ** -0.5),
        "w_sh_gate": nrm(ks[25], (L, D, SHARED_FF), D ** -0.5),
        "w_sh_up": nrm(ks[26], (L, D, SHARED_FF), D ** -0.5),
        "w_sh_down": nrm(ks[27], (L, SHARED_FF, D), SHARED_FF ** -0.5),
    }


def reference(x, c, positions, norm_mix_g, norm_ffn_g, w_ada, b_ada, w_in,
              gm_ln_g, gm_ln_b, gm_ws, gm_bs, q_a_g, w_q_up, kv_a_g, w_kv_up,
              q_norm_g, k_norm_g, out_norm_g, w_out, w_router, router_bias,
              w_exp_gate, w_exp_up, w_exp_down, w_sh_gate, w_sh_up, w_sh_down):
    cos, sin = rope_tables(positions)
    c_act = jax.nn.silu(c)
    o1 = 2 * GM_WIDTH
    o2 = o1 + Q_LORA
    o3 = o2 + KV_LORA
    for l in range(DEPTH):
        mod = c_act @ w_ada[l] + b_ada[l]
        sh1, sc1, g1, sh2, sc2, g2 = [m[:, None, :] for m in jnp.split(mod, 6, axis=-1)]
        h = rms_norm(x, norm_mix_g[l]) * (1.0 + sc1) + sh1
        proj = h @ w_in[l]
        gm_out = gmlp_mixer(proj[..., :o1], gm_ln_g[l], gm_ln_b[l], gm_ws[l], gm_bs[l])
        mla_out = mla_mixer(proj[..., o1:o2], proj[..., o2:o3], proj[..., o3:], cos, sin,
                            q_a_g[l], w_q_up[l], kv_a_g[l], w_kv_up[l], q_norm_g[l], k_norm_g[l])
        mixed = jnp.concatenate([rms_norm(gm_out, out_norm_g[l, :GM_WIDTH]),
                                 rms_norm(mla_out, out_norm_g[l, GM_WIDTH:])], axis=-1)
        x = x + g1 * (mixed @ w_out[l])
        h = rms_norm(x, norm_ffn_g[l]) * (1.0 + sc2) + sh2
        x = x + g2 * moe_ffn(h, w_router[l], router_bias[l], w_exp_gate[l], w_exp_up[l],
                             w_exp_down[l], w_sh_gate[l], w_sh_up[l], w_sh_down[l])
    return x
```

```cpp
#include <hip/hip_runtime.h>
#include <cstdio>
#include <cstdint>

#define DI __device__ __forceinline__
#define LAS __attribute__((address_space(3)))
typedef unsigned short bf16;
typedef short bf16x8 __attribute__((ext_vector_type(8)));
typedef float f32x2 __attribute__((ext_vector_type(2)));
typedef float f32x4 __attribute__((ext_vector_type(4)));
typedef float f32x16 __attribute__((ext_vector_type(16)));
typedef unsigned u32x2 __attribute__((ext_vector_type(2)));
typedef unsigned u32x4 __attribute__((ext_vector_type(4)));
typedef __bf16 bf16x2v __attribute__((ext_vector_type(2)));

#ifndef OUT_MID
#define OUT_MID 1
#endif
#ifndef N_LAUNCH_MODE
#define N_LAUNCH_MODE 1
#endif

constexpr int NTOK = 32768, DM = 1024, SEQ = 4096, NB = 8, NH = 8, QKD = 96, VD = 64;
constexpr int INC = 1696, INP = 1792, LATW = 768, QL = 384, KVL = 256;
constexpr int NE = 64, NE1 = 65, FF = 256, HALFTOK = 16384, LCAP = 16384;
constexpr float EPS = 1e-6f;
constexpr float QSCALE = 0.10206207261596575f * 1.4426950408889634f;

constexpr size_t MiB = 1u << 20;
constexpr size_t WS_CTL = 0, CTL_BYTES = 256 * 1024;
constexpr size_t WS_MOD = 1 * MiB;
constexpr size_t WS_SMB = 1 * MiB + 512 * 1024;
constexpr size_t WS_COS = 2 * MiB, WS_SIN = 4 * MiB;
constexpr size_t WS_WIN = 6 * MiB;
constexpr size_t WS_WQ = 13 * MiB;
constexpr size_t WS_WKV = 15 * MiB;
constexpr size_t WS_WOUT = 16 * MiB;
constexpr size_t WS_WR = 20 * MiB;
constexpr size_t WS_WS = 20 * MiB + 512 * 1024;
constexpr size_t WS_RGM = 21 * MiB;
constexpr size_t WS_SSQ = 21 * MiB + 256 * 1024;
constexpr size_t WS_WGU = 23 * MiB;
constexpr size_t WS_WD = 88 * MiB;
constexpr size_t WGU_L = (size_t)65 * 512 * 1024, WD_L = (size_t)65 * 1024 * 256;
constexpr int CONV_ITEMS = 65 * 384, CONV_TAIL = 8192;
constexpr size_t WS_H = 121 * MiB;
constexpr size_t WS_OV = 185 * MiB;
constexpr size_t WS_UV = WS_OV;
constexpr size_t WS_LAT = WS_OV + 64 * MiB;
constexpr size_t WS_Q = WS_OV + 112 * MiB;
constexpr size_t WS_K = WS_OV + 160 * MiB;
constexpr size_t WS_VT = WS_OV + 208 * MiB;
constexpr size_t WS_MIX = WS_OV + 240 * MiB;
constexpr size_t WS_LIST = WS_OV;
constexpr size_t WS_ACT = WS_OV + 17 * MiB;
constexpr size_t WS_Y = WS_OV + 98 * MiB;
constexpr size_t WS_XB = WS_OV + 304 * MiB;
constexpr size_t WS_H8 = WS_OV + 368 * MiB;
constexpr size_t WS_END = WS_OV + 400 * MiB;
constexpr int CW_BAR = 1024;
constexpr int CW_CNT = 8192;

constexpr int RING_BYTES = 131072;
constexpr int LDSCTL_OFF = RING_BYTES;
constexpr int LC_BAR = 0;
constexpr int LC_TB = 64;
constexpr int LC_CNT = 64 + 66 * 4;
constexpr int LC_WTAB = 768;
constexpr int LC_UTAB = 1024;
constexpr int LC_PRE = 2048;
constexpr int LC_NXT = 6144;
constexpr int LDS_BYTES = 147456;

DI unsigned pk2(float lo, float hi) { f32x2 v = {lo, hi}; bf16x2v r = __builtin_convertvector(v, bf16x2v); return __builtin_bit_cast(unsigned, r); }
DI float bflo(unsigned w) { return __uint_as_float(w << 16); }
DI float bfhi(unsigned w) { return __uint_as_float(w & 0xffff0000u); }
DI float bf2f(unsigned short h) { return __uint_as_float((unsigned)h << 16); }
DI unsigned short f2bf(float f) { return (unsigned short)(pk2(f, 0.f) & 0xffffu); }
DI float shx(float v, int m, int lane) { return __builtin_bit_cast(float, __builtin_amdgcn_ds_bpermute((lane ^ m) << 2, __builtin_bit_cast(int, v))); }
DI int shxi(int v, int m, int lane) { return __builtin_amdgcn_ds_bpermute((lane ^ m) << 2, v); }
DI float shf(float v, int src) { return __builtin_bit_cast(float, __builtin_amdgcn_ds_bpermute(src << 2, __builtin_bit_cast(int, v))); }
DI float wave_sum(float v, int lane) {
#pragma unroll
    for (int o = 1; o < 64; o <<= 1) v += shx(v, o, lane);
    return v;
}
DI const void* uniform_ptr(const void* p) { const unsigned long long v = (unsigned long long)p; const unsigned lo = (unsigned)__builtin_amdgcn_readfirstlane((int)(unsigned)v), hi = (unsigned)__builtin_amdgcn_readfirstlane((int)(unsigned)(v >> 32)); return (const void*)(((unsigned long long)hi << 32) | lo); }
DI int lane_id() { int l; asm volatile("v_mbcnt_lo_u32_b32 %0, -1, 0\n\tv_mbcnt_hi_u32_b32 %0, -1, %0" : "=v"(l)); return l; }
#define MFMA32(a, b, c) __builtin_amdgcn_mfma_f32_32x32x16_bf16((a), (b), (c), 0, 0, 0)
DI f32x16 zero16() { f32x16 z;
#pragma unroll
    for (int i = 0; i < 16; ++i) z[i] = 0.f; return z; }

namespace pg8 {
constexpr int BM = 256, BK = 64, HALF = 128, HTB = HALF * BK * 2, STAGE_BYTES = 8 * HTB, NXCD = 8, WGM = 8;
__host__ __device__ __forceinline__ int lds_byte(int r, int c) { const int st = (r >> 4) * 2 + (c >> 5), rr = r & 15, cc = c & 31, ob = rr * 64 + cc * 2; return st * 1024 + (ob ^ (((ob >> 9) & 1) << 5)); }
__host__ __device__ __forceinline__ void stage_rc(int b, int& R, int& C) { const int st = b / 1024, sb = b % 1024, swz = sb ^ (((sb >> 9) & 1) << 5); R = (st >> 1) * 16 + swz / 64; C = (st & 1) * 32 + (swz % 64) / 2; }
__host__ __device__ __forceinline__ int perm32(int rho) { const int n = rho >> 4, i = rho & 15; return 8 * (i >> 2) + 4 * n + (i & 3); }

struct Unit { int pm, pn, e, p0, cnt; };

DI f32x2 gelu_pk(f32x2 v) {
    const f32x2 av = __builtin_elementwise_abs(v), d = av * 0.2316418882f + 1.0f;
    f32x2 t; t.x = __builtin_amdgcn_rcpf(d.x); t.y = __builtin_amdgcn_rcpf(d.y);
    f32x2 q = t * 0.5307027145f + (-0.7265760135f); q = q * t + 0.7107068705f; q = q * t + (-0.142248368f); q = q * t + 0.127414796f; q = q * t;
    const f32x2 s = (v * v) * (-0.72134752044f);
    f32x2 e; e.x = __builtin_amdgcn_exp2f(s.x); e.y = __builtin_amdgcn_exp2f(s.y);
    const f32x2 m = v * (q * e), r = v - m;
    f32x2 o; o.x = v.x < 0.f ? m.x : r.x; o.y = v.y < 0.f ? m.y : r.y; return o;
}

typedef int i32x8 __attribute__((ext_vector_type(8)));
template <class Epi, class Sched, bool FP8 = false>
DI void gemm_phase(LAS unsigned char* lds_in, const int wave_in, const bf16* Abase, const bf16* Btbase, const int K_in, const int lda, const Sched& S, const Epi& E) {
    int K = K_in; asm volatile("" : "+s"(K));
    LAS unsigned char* lds; { unsigned lb = (unsigned)(size_t)lds_in; asm volatile("" : "+s"(lb)); lds = (LAS unsigned char*)lb; }
    const int lane_ = lane_id();
    const int wid = wave_in, lane = lane_, tid = wid * 64 + lane, wr = wid >> 2, wc = wid & 3, fr = lane & 15, fq = lane >> 4;
    const int nt = K / BK;
    unsigned voffB[2];
#pragma unroll
    for (int i = 0; i < 2; ++i) { int R_, C_; stage_rc(tid * 16 + i * 8192, R_, C_); const int Rb = Epi::bsrc(R_);
        voffB[i] = (unsigned)(Rb * K + C_) * 2u; }
    LAS u32x4* park = (LAS u32x4*)(lds + 131072 + 8192) + tid;
    LAS unsigned char* const prel = lds + 131072 + LC_PRE + wid * 512;
    LAS unsigned char* const nxl = lds + 131072 + LC_NXT + (wid >> 2) * 1024;
    constexpr bool EXACT = Epi::NST >= 0;
    constexpr int XN = EXACT ? Epi::NST + Epi::NPRE + Sched::NDMA : 0;
    static_assert(XN + 8 <= 63, "vmcnt range");
    const size_t kstep = (size_t)(BK * 2);
    const size_t hstep = (size_t)Epi::HROWS * K * 2;
    unsigned ldsw = (unsigned)wid * 1024u;
    const int aoff = FP8 ? lds_byte(wr * 64 + fr, 16 * (fq & 1)) + 1024 * (fq >> 1) : lds_byte(wr * 64 + fr, fq * 8), boff = FP8 ? lds_byte(wc * 32 + fr, 16 * (fq & 1)) + 1024 * (fq >> 1) : lds_byte(wc * 32 + fr, fq * 8);
    constexpr int KSTR = FP8 ? 16 : 1024;
    const char* Ab = (const char*)Abase;
#define PG8_SA(b, h) (((b) * 2 + (h)) * HTB)
#define PG8_SB(b, h) ((4 + (b) * 2 + (h)) * HTB)
#define PG8_STAGE(bufoff, gbase, voff) do { _Pragma("unroll") for (int _i = 0; _i < 2; ++_i) \
        __builtin_amdgcn_global_load_lds((const unsigned*)((const char*)(gbase) + (voff)[_i]), (LAS unsigned*)(lds + (bufoff) + ldsw + _i * 8192), 16, 0, 0); } while (0)
#define PG8_LDA(dst, b, h) do { _Pragma("unroll") for (int m = 0; m < 4; ++m) _Pragma("unroll") for (int k = 0; k < 2; ++k) dst[m][k] = *(const LAS bf16x8*)(lds + PG8_SA(b, h) + aoff + m * 2048 + k * KSTR); } while (0)
#define PG8_LDB(dst, b, h) do { _Pragma("unroll") for (int n = 0; n < 2; ++n) _Pragma("unroll") for (int k = 0; k < 2; ++k) dst[n][k] = *(const LAS bf16x8*)(lds + PG8_SB(b, h) + boff + n * 2048 + k * KSTR); } while (0)
#define PG8_MMA(ai, bj, At, Bt) do { __builtin_amdgcn_s_setprio(1); _Pragma("unroll") for (int m = 0; m < 4; ++m) _Pragma("unroll") for (int n = 0; n < 2; ++n) { \
        if constexpr (FP8) { const i32x8 a8 = __builtin_bit_cast(i32x8, __builtin_shufflevector(At[m][0], At[m][1], 0, 1, 2, 3, 4, 5, 6, 7, 8, 9, 10, 11, 12, 13, 14, 15)), b8 = __builtin_bit_cast(i32x8, __builtin_shufflevector(Bt[n][0], Bt[n][1], 0, 1, 2, 3, 4, 5, 6, 7, 8, 9, 10, 11, 12, 13, 14, 15)); \
            acc[ai][bj][m][n] = __builtin_amdgcn_mfma_scale_f32_16x16x128_f8f6f4(b8, a8, acc[ai][bj][m][n], 0, 0, 0, 0x7f7f7f7f, 0, 0x7f7f7f7f); } \
        else { _Pragma("unroll") for (int k = 0; k < 2; ++k) acc[ai][bj][m][n] = __builtin_amdgcn_mfma_f32_16x16x32_bf16(Bt[n][k], At[m][k], acc[ai][bj][m][n], 0, 0, 0); } } \
        __builtin_amdgcn_s_setprio(0); } while (0)
#define PG8_WAIT_V(n) asm volatile("s_waitcnt vmcnt(" #n ")" ::: "memory")
#define PG8_WAIT_F() do { if constexpr (EXACT) asm volatile("s_waitcnt vmcnt(%1)\n\ts_cmp_lg_u32 %0, 0\n\ts_cbranch_scc1 1f\n\ts_waitcnt vmcnt(8)\n1:" :: "s"(fflag), "i"(8 + XN) : "scc", "memory"); \
        else asm volatile("s_waitcnt vmcnt(8)" ::: "memory"); } while (0)
#define PG8_WAIT_L(n) asm volatile("s_waitcnt lgkmcnt(" #n ")" ::: "memory")
#define PG8_BAR __builtin_amdgcn_s_barrier()
#define PG8_SCHED __builtin_amdgcn_sched_barrier(0)
    Unit cur; int ui = 0;
    if (!S.next(0, cur)) return;
    f32x4 acc[2][2][4][2];
#pragma unroll
    for (int a = 0; a < 2; ++a)
#pragma unroll
        for (int b = 0; b < 2; ++b)
#pragma unroll
            for (int m = 0; m < 4; ++m)
#pragma unroll
                for (int n = 0; n < 2; ++n) acc[a][b][m][n] = (f32x4){0.f, 0.f, 0.f, 0.f};
    bf16x8 At[4][2], B0[2][2], B1[2][2];
    unsigned oc[2][2];
    S.a_offs(cur, tid, lda, oc);
    E.prefetch(cur, prel, wr, lane);
    const char* cB = (const char*)Btbase + S.b_off(cur, K);
    PG8_STAGE(PG8_SB(0, 0), cB, voffB); PG8_STAGE(PG8_SB(0, 1), cB + hstep, voffB); PG8_STAGE(PG8_SA(0, 0), Ab, oc[0]); PG8_STAGE(PG8_SA(0, 1), Ab, oc[1]);
    if (wr == 1) PG8_BAR;
    PG8_WAIT_V(2); PG8_BAR;
    PG8_STAGE(PG8_SB(1, 0), cB + kstep, voffB); PG8_STAGE(PG8_SA(1, 0), Ab + kstep, oc[0]); PG8_STAGE(PG8_SB(1, 1), cB + hstep + kstep, voffB); PG8_STAGE(PG8_SA(1, 1), Ab + kstep, oc[1]);
    PG8_WAIT_V(8); PG8_BAR;
    for (;;) {
        bool has_next; const char* nB = cB;
        { unsigned on[2][2]; Unit nxt;
          has_next = S.next(ui + 1, nxt);
          if constexpr (Sched::NDMA != 0) { if (has_next) nB = (const char*)Btbase + S.b_off(nxt, K); else nxt = cur; S.dma_next(nxt, nxl, wid, lane); }
          else {
          if (has_next) { S.a_offs(nxt, tid, lda, on); nB = (const char*)Btbase + S.b_off(nxt, K); }
          else {
#pragma unroll
            for (int h = 0; h < 2; ++h)
#pragma unroll
                for (int i = 0; i < 2; ++i) on[h][i] = oc[h][i];
          }
          *park = (u32x4){on[0][0], on[0][1], on[1][0], on[1][1]}; } }
        int fflag = __builtin_amdgcn_readfirstlane((EXACT && ui > 0) ? 1 : 0); asm volatile("" : "+s"(fflag));
        for (int t = 0; t < nt; t += 2) {
            const bool last = (t == nt - 2);
            asm volatile("" : "+s"(ldsw));
            if constexpr (Epi::MID) { if (t == (nt >> 1)) E.mid(acc, cur, wr, fr); }
            const char* a2 = last ? Ab : Ab + (size_t)(t + 2) * kstep; const char* b2 = last ? nB : cB + (size_t)(t + 2) * kstep;
            const char* a3 = a2 + kstep; const char* b3 = b2 + kstep;
            PG8_LDB(B0, 0, 0); PG8_LDB(B1, 0, 1); PG8_SCHED; PG8_LDA(At, 0, 0);
            if (last) { if constexpr (Sched::NDMA != 0) S.offs_lds(nxl, tid, lda, oc); else { const u32x4 pv = *park; oc[0][0] = pv.x; oc[0][1] = pv.y; oc[1][0] = pv.z; oc[1][1] = pv.w; } }
            PG8_WAIT_F(); PG8_WAIT_L(0); PG8_BAR; PG8_MMA(0, 0, At, B0); PG8_MMA(0, 1, At, B1); PG8_BAR; PG8_SCHED;
            PG8_LDA(At, 0, 1); PG8_STAGE(PG8_SB(0, 0), b2, voffB); PG8_STAGE(PG8_SB(0, 1), b2 + hstep, voffB); PG8_STAGE(PG8_SA(0, 0), a2, oc[0]);
            PG8_WAIT_F(); PG8_WAIT_L(0); PG8_BAR; PG8_MMA(1, 0, At, B0); PG8_MMA(1, 1, At, B1); PG8_BAR; PG8_SCHED;
            PG8_LDB(B0, 1, 0); PG8_LDB(B1, 1, 1); PG8_SCHED; PG8_LDA(At, 1, 0); PG8_STAGE(PG8_SA(0, 1), a2, oc[1]);
            PG8_WAIT_F(); PG8_WAIT_L(0); PG8_BAR; PG8_MMA(0, 0, At, B0); PG8_MMA(0, 1, At, B1); PG8_BAR; PG8_SCHED;
            PG8_LDA(At, 1, 1); PG8_STAGE(PG8_SB(1, 0), b3, voffB); PG8_STAGE(PG8_SB(1, 1), b3 + hstep, voffB); PG8_STAGE(PG8_SA(1, 0), a3, oc[0]);
            PG8_WAIT_V(8); PG8_WAIT_L(0); PG8_BAR; PG8_MMA(1, 0, At, B0); PG8_MMA(1, 1, At, B1); PG8_BAR; PG8_SCHED;
            PG8_STAGE(PG8_SA(1, 1), a3, oc[1]);
            if constexpr (EXACT) { fflag = __builtin_amdgcn_readfirstlane(0); asm volatile("" : "+s"(fflag)); }
        }
        asm volatile("" ::: "memory"); PG8_SCHED;
        if (wr == 0) PG8_BAR;
        E(acc, prel, cur, wr, wc, fr, fq);
        asm volatile("" ::: "memory"); PG8_SCHED;
        if (!has_next) break;
#pragma unroll
        for (int a = 0; a < 2; ++a)
#pragma unroll
            for (int b = 0; b < 2; ++b)
#pragma unroll
                for (int m = 0; m < 4; ++m)
#pragma unroll
                    for (int n = 0; n < 2; ++n) acc[a][b][m][n] = (f32x4){0.f, 0.f, 0.f, 0.f};
        ++ui; (void)S.next(ui, cur); cB = (const char*)Btbase + S.b_off(cur, K);
        E.prefetch(cur, prel, wr, lane);
        if (wr == 1) PG8_BAR;
    }
    PG8_WAIT_V(0);
    PG8_BAR;
#undef PG8_SA
#undef PG8_SB
#undef PG8_STAGE
#undef PG8_LDA
#undef PG8_LDB
#undef PG8_MMA
#undef PG8_WAIT_V
#undef PG8_WAIT_F
#undef PG8_WAIT_L
#undef PG8_BAR
#undef PG8_SCHED
}

struct DenseSched {
    static constexpr int NDMA = 0;
    DI void dma_next(const Unit&, LAS unsigned char*, int, int) const {}
    DI void offs_lds(LAS unsigned char*, int, int, unsigned (&)[2][2]) const {}
    int nM, nN, nwg, G, c;
    DI void init(int M, int N, int G_, int c_) { nM = M / BM; nN = N / BM; nwg = nM * nN; G = G_; c = c_; }
    DI bool next(int i, Unit& u) const {
        const long L = (long)i * G + c; if (L >= nwg) return false;
        int wgid = (int)L; { const int q = nwg / NXCD, r = nwg % NXCD, xcd = wgid % NXCD, off = wgid / NXCD; wgid = (xcd < r ? xcd * (q + 1) : r * (q + 1) + (xcd - r) * q) + off; }
        const int nig = WGM * nN, gid = wgid / nig, fm = gid * WGM, gsz = (nM - fm) < WGM ? (nM - fm) : WGM;
        u.pm = fm + ((wgid % nig) % gsz); u.pn = (wgid % nig) / gsz; u.e = i; u.p0 = 0; u.cnt = 0; return true;
    }
    DI void a_offs(const Unit& u, int tid, int lda, unsigned (&o)[2][2]) const {
#pragma unroll
        for (int i = 0; i < 2; ++i) { int R, C; stage_rc(tid * 16 + i * 8192, R, C);
#pragma unroll
            for (int h = 0; h < 2; ++h) o[h][i] = (unsigned)((u.pm * BM + h * HALF + R) * lda + C) * 2u; }
    }
    DI size_t b_off(const Unit& u, int K) const { return (size_t)u.pn * BM * K * 2; }
};
}

#define XB_TMO      128
#define XB_XCNT(j)  (256  + 64 * (j))
#define XB_XSUB(j)  (1280 + 64 * (j))
#define XB_XGEN(j)  (2304 + 64 * (j))
#define XB_TOP      3328
#define XB_TOPGEN   3392
#define XCD_BAR_WORDS 3456
#define XB_SPIN_CAP (1u << 18)
DI unsigned xb_ld(unsigned* p)              { return __hip_atomic_load(p, __ATOMIC_RELAXED, __HIP_MEMORY_SCOPE_AGENT); }
DI unsigned xb_add(unsigned* p, unsigned v) { return __hip_atomic_fetch_add(p, v, __ATOMIC_RELAXED, __HIP_MEMORY_SCOPE_AGENT); }
DI unsigned xb_xcc_id() { return (unsigned)__builtin_amdgcn_s_getreg((3 << 11) | 20) & 0xFu; }
#define XB_SPIN(cond, bar) do { unsigned _sp = 0; while (cond) { __builtin_amdgcn_s_sleep(1); \
    if ((++_sp & 255u) == 0u) { if (xb_ld(&(bar)[XB_TMO])) break; if (_sp > XB_SPIN_CAP) { atomicAdd(&(bar)[XB_TMO], 1u); break; } } } } while (0)
struct XcdBarrier { unsigned* bar; unsigned x; volatile LAS unsigned* st; };
DI XcdBarrier xcd_barrier_post(unsigned* bar, volatile LAS unsigned* st) {
    XcdBarrier b; b.bar = bar; b.x = xb_xcc_id(); b.st = st;
    if (threadIdx.x == 0) (void)xb_add(&bar[XB_XCNT(b.x)], 1u);
    return b;
}
DI void xcd_barrier_complete(unsigned* bar, unsigned x, unsigned& nloc, unsigned& nx) {
    const unsigned G = gridDim.x * gridDim.y * gridDim.z;
    unsigned sum, cnt, mine, sp = 0u;
    for (;;) {
        sum = 0u; cnt = 0u; mine = 0u;
#pragma unroll
        for (unsigned j = 0; j < 16; ++j) { const unsigned c = xb_ld(&bar[XB_XCNT(j)]); sum += c; cnt += (c > 0u) ? 1u : 0u; mine = (j == x) ? c : mine; }
        if (sum == G) break;
        __builtin_amdgcn_s_sleep(1);
        if ((++sp & 255u) == 0u) { if (xb_ld(&bar[XB_TMO])) break; if (sp > XB_SPIN_CAP) { atomicAdd(&bar[XB_TMO], 1u); break; } }
    }
    nloc = mine > 0u ? mine : 1u; nx = cnt > 0u ? cnt : 1u;
}
DI void xcd_barrier(const XcdBarrier& b, int wave) {
    asm volatile("s_waitcnt vmcnt(0)" ::: "memory");
    __syncthreads();
    if (wave == 0 && lane_id() == 0) {
        unsigned* bar = b.bar;
        __builtin_amdgcn_s_waitcnt(0);
        unsigned nloc = b.st[0], nx = b.st[1];
        if (nloc == 0u) { xcd_barrier_complete(bar, b.x, nloc, nx); b.st[0] = nloc; b.st[1] = nx; }
        const unsigned old = xb_add(&bar[XB_XSUB(b.x)], 1u);
        const unsigned gen = old / nloc;
        if (old + 1u == (gen + 1u) * nloc) {
            __builtin_amdgcn_fence(__ATOMIC_RELEASE, "agent");
            asm volatile("s_waitcnt vmcnt(0)" ::: "memory");
            const unsigned og = xb_add(&bar[XB_TOP], 1u);
            const unsigned tg = og / nx;
            if (og + 1u == (tg + 1u) * nx) xb_add(&bar[XB_TOPGEN], 1u);
            else XB_SPIN(xb_ld(&bar[XB_TOPGEN]) == tg, bar);
            __builtin_amdgcn_fence(__ATOMIC_ACQUIRE, "agent");
            xb_add(&bar[XB_XGEN(b.x)], 1u);
            asm volatile("s_waitcnt vmcnt(0)" ::: "memory");
        } else {
            XB_SPIN(xb_ld(&bar[XB_XGEN(b.x)]) == gen, bar);
            __builtin_amdgcn_fence(__ATOMIC_ACQUIRE, "agent");
            asm volatile("s_waitcnt vmcnt(0)" ::: "memory");
        }
    }
    __syncthreads();
}

#define GAS __attribute__((address_space(1)))
struct Args {
    const GAS float* in[28];
    GAS float* out; GAS unsigned char* ws;
    int ph_lo, ph_hi;
    int probe, G;
};
enum { I_X = 0, I_C, I_POS, I_NMG, I_NFG, I_WADA, I_BADA, I_WIN, I_LNG, I_LNB, I_GWS, I_GBS, I_QAG, I_WQUP, I_KVAG, I_WKVUP, I_QNG, I_KNG, I_ONG, I_WOUT,
       I_WR, I_RB, I_WEG, I_WEU, I_WED, I_WSG, I_WSU, I_WSD };

struct Frame {
    LAS unsigned char* lds;
    unsigned* ctl;
    unsigned char* ws;
    const __attribute__((address_space(4))) struct Args* ka;
    int tid, lane, wave, vcu, G;
};
typedef const __attribute__((address_space(4))) struct Args KArgs;
#define AIN(i) ((const float*)a.in[i])
extern __shared__ __attribute__((aligned(16))) unsigned char lds_raw[];
DI unsigned hw_wave_key() { return (unsigned)__builtin_amdgcn_s_getreg((5 << 11) | 4) & 63u; }
DI Frame frame_now() {
    Frame F;
    unsigned lb = (unsigned)(size_t)(LAS unsigned char*)lds_raw; asm volatile("" : "+s"(lb)); F.lds = (LAS unsigned char*)(size_t)lb;
    F.ka = (KArgs*)__builtin_amdgcn_kernarg_segment_ptr(); asm volatile("" : "+s"(F.ka));
    F.ws = (unsigned char*)F.ka->ws; F.ctl = (unsigned*)F.ws;
    F.G = F.ka->G; const int bx = (int)__builtin_amdgcn_workgroup_id_x(); F.vcu = (F.G % 8 == 0) ? (bx % 8) * (F.G / 8) + bx / 8 : bx;
    const unsigned wv = *(volatile LAS unsigned char*)(F.lds + LDSCTL_OFF + LC_WTAB + hw_wave_key());
    F.wave = __builtin_amdgcn_readfirstlane((int)wv);
    int ln = lane_id(); F.lane = ln; F.tid = F.wave * 64 + ln; return F; }
DI Frame launder(const Frame&) { return frame_now(); }
DI int launder_s(int x) { asm volatile("" : "+s"(x)); return x; }

DI void tr_item(const float* src, int N, bf16* dst, int ldk, const float* scale, int k0, int n0, int drow0, int dk0, LAS float* scr, int lane, int mode, size_t lo_off) {
    { f32x4 t[8];
#pragma unroll
      for (int i = 0; i < 8; ++i) t[i] = *(const f32x4*)(src + (size_t)(k0 + 8 * i + (lane >> 3)) * N + n0 + 4 * (lane & 7));
#pragma unroll
      for (int i = 0; i < 8; ++i) { const int kk = 8 * i + (lane >> 3); f32x4 v = t[i]; if (scale) v = v * scale[k0 + kk];
#pragma unroll
          for (int q = 0; q < 4; ++q) scr[kk * 33 + 4 * (lane & 7) + q] = v[q]; } }
    asm volatile("s_waitcnt lgkmcnt(0)" ::: "memory");
    const int c = lane & 7;
#pragma unroll
    for (int j = 0; j < 4; ++j) { const int n = (lane >> 3) + 8 * j; const LAS float* s = scr + (8 * c) * 33 + n;
        float v[8];
#pragma unroll
        for (int q = 0; q < 8; ++q) v[q] = s[q * 33];
        u32x4 o; o.x = pk2(v[0], v[1]); o.y = pk2(v[2], v[3]); o.z = pk2(v[4], v[5]); o.w = pk2(v[6], v[7]);
        bf16* dp = dst + (size_t)(drow0 + n) * ldk + dk0 + 8 * c;
        *(u32x4*)dp = o;
        if (mode == 1) {
            float r[8];
#pragma unroll
            for (int q = 0; q < 4; ++q) { r[2 * q] = v[2 * q] - bflo(o[q]); r[2 * q + 1] = v[2 * q + 1] - bfhi(o[q]); }
            u32x4 lo; lo.x = pk2(r[0], r[1]); lo.y = pk2(r[2], r[3]); lo.z = pk2(r[4], r[5]); lo.w = pk2(r[6], r[7]);
            *(u32x4*)(dp + lo_off) = lo;
        }
    }
    asm volatile("s_waitcnt lgkmcnt(0)" ::: "memory");
}

DI void tr_item8(const float* src, int N, unsigned char* dst8, int ldk, int k0, int n0, int drow0, int dk0, LAS float* scr, int lane) {
    { f32x4 t[8];
#pragma unroll
      for (int i = 0; i < 8; ++i) t[i] = *(const f32x4*)(src + (size_t)(k0 + 8 * i + (lane >> 3)) * N + n0 + 4 * (lane & 7));
#pragma unroll
      for (int i = 0; i < 8; ++i) { const int kk = 8 * i + (lane >> 3);
#pragma unroll
          for (int q = 0; q < 4; ++q) scr[kk * 33 + 4 * (lane & 7) + q] = t[i][q]; } }
    asm volatile("s_waitcnt lgkmcnt(0)" ::: "memory");
    const int c = lane & 7;
#pragma unroll
    for (int j = 0; j < 4; ++j) { const int n = (lane >> 3) + 8 * j; const LAS float* s_ = scr + (8 * c) * 33 + n;
        float v[8];
#pragma unroll
        for (int q = 0; q < 8; ++q) v[q] = s_[q * 33] * 64.0f;
        int p0 = __builtin_amdgcn_cvt_pk_fp8_f32(v[0], v[1], 0, false); p0 = __builtin_amdgcn_cvt_pk_fp8_f32(v[2], v[3], p0, true);
        int p1 = __builtin_amdgcn_cvt_pk_fp8_f32(v[4], v[5], 0, false); p1 = __builtin_amdgcn_cvt_pk_fp8_f32(v[6], v[7], p1, true);
        *(u32x2*)(dst8 + (size_t)(drow0 + n) * ldk + dk0 + 8 * c) = (u32x2){(unsigned)p0, (unsigned)p1}; }
    asm volatile("s_waitcnt lgkmcnt(0)" ::: "memory");
}

DI void conv_experts(const Frame& F0, int l, int it_lo, int it_hi, int part, int nparts) {
    const Frame F = launder(F0); KArgs& a = *F.ka; l = launder_s(l);
    LAS float* scr = (LAS float*)(F.lds + F.wave * 16384);
    const int gw = part * 8 + F.wave, NGW = nparts * 8;
    unsigned char* WGU8 = (unsigned char*)(F.ws + WS_WGU) + (size_t)l * WGU_L; unsigned char* WD8 = (unsigned char*)(F.ws + WS_WD) + (size_t)l * WD_L;
    for (int it = it_lo + gw; it < it_hi; it += NGW) {
        const int e = it / 384, r = it % 384, kind = r >> 7, q = r & 127;
        if (kind < 2) {
            const float* src = (e < NE) ? (AIN(kind == 0 ? I_WEG : I_WEU) + ((size_t)l * NE + e) * 1024 * 256) : (AIN(kind == 0 ? I_WSG : I_WSU) + (size_t)l * 1024 * 256);
            const int kb = q >> 3, nb = q & 7, n0 = nb * 32;
            const int drow0 = (n0 >> 7) * 256 + kind * 128 + (n0 & 127);
            tr_item8(src, 256, WGU8 + (size_t)e * 512 * 1024, 1024, kb * 64, n0, drow0, kb * 64, scr, F.lane);
        } else {
            const float* src = (e < NE) ? (AIN(I_WED) + ((size_t)l * NE + e) * 256 * 1024) : (AIN(I_WSD) + (size_t)l * 256 * 1024);
            const int kb = q >> 5, nb = q & 31;
            tr_item8(src, 1024, WD8 + (size_t)e * 1024 * 256, 256, kb * 64, nb * 32, nb * 32, kb * 64, scr, F.lane);
        }
    }
}

DI void p0_prologue(const Frame& F0) {
    const Frame F = launder(F0); KArgs& a = *F.ka;
    const int tid = F.tid, lane = F.lane, wave = F.wave;
    {
        LAS float* cact = (LAS float*)F.lds;
        LAS float* red = (LAS float*)(F.lds + 32768);
        float* mod = (float*)(F.ws + WS_MOD);
        for (int it = blockIdx.x; it < 192; it += F.G) {
            const int l = it / 96, col0 = (it % 96) * 64;
            for (int i = tid; i < 8192; i += 512) { const float c = AIN(I_C)[i]; cact[i] = c / (1.f + expf(-c)); }
            __syncthreads();
            const int kg = tid >> 4, cq = tid & 15;
            float acc[8][4];
#pragma unroll
            for (int b = 0; b < 8; ++b)
#pragma unroll
                for (int j = 0; j < 4; ++j) acc[b][j] = 0.f;
            const float* wp = AIN(I_WADA) + (size_t)l * 1024 * 6144 + col0 + 4 * cq;
            for (int i = 0; i < 32; ++i) { const int k = kg + 32 * i; const f32x4 w = *(const f32x4*)(wp + (size_t)k * 6144);
#pragma unroll
                for (int b = 0; b < 8; ++b) { const float ca = cact[b * 1024 + k];
#pragma unroll
                    for (int j = 0; j < 4; ++j) acc[b][j] += ca * w[j]; } }
#pragma unroll
            for (int b = 0; b < 8; ++b)
#pragma unroll
                for (int j = 0; j < 4; ++j) { float v = acc[b][j]; v += shx(v, 16, lane); v += shx(v, 32, lane); if (lane < 16) red[wave * 512 + b * 64 + 4 * cq + j] = v; }
            __syncthreads();
            { float s = 0.f;
#pragma unroll
              for (int w = 0; w < 8; ++w) s += red[w * 512 + tid];
              const int b = tid >> 6, c = tid & 63;
              mod[((size_t)l * 8 + b) * 6144 + col0 + c] = s + AIN(I_BADA)[l * 6144 + col0 + c]; }
            __syncthreads();
        }
    }
    {
        float* cosT = (float*)(F.ws + WS_COS); float* sinT = (float*)(F.ws + WS_SIN);
        const int* pos = (const int*)AIN(I_POS);
        for (int i = F.vcu * 512 + tid; i < NTOK * 16; i += F.G * 512) {
            const int tok = i >> 4, fi = i & 15;
            double f = (fi & 3) == 0 ? 1.0 : ((fi & 3) == 1 ? 0.5623413251903491 : ((fi & 3) == 2 ? 0.31622776601683794 : 0.1778279410038923));
            const int dec = fi >> 2; f *= (dec == 0 ? 1.0 : (dec == 1 ? 0.1 : (dec == 2 ? 0.01 : 0.001)));
            const float invf = (float)f;
            const float angf = (float)pos[tok] * invf;
            const double ang = (double)angf;
            const double n = rint(ang * 0.15915494309189535);
            double r = fma(-n, 6.283185307179586, ang); r = fma(-n, 2.4492935982947064e-16, r);
            const double q = rint(r * 0.6366197723675814);
            double t = fma(-q, 1.5707963267948966, r); t = fma(-q, 6.123233995736766e-17, t);
            const double t2 = t * t;
            const double sn = t * (1.0 + t2 * (-1.0 / 6 + t2 * (1.0 / 120 + t2 * (-1.0 / 5040 + t2 * (1.0 / 362880 + t2 * (-1.0 / 39916800 + t2 * (1.0 / 6227020800.0)))))));
            const double cs = 1.0 + t2 * (-0.5 + t2 * (1.0 / 24 + t2 * (-1.0 / 720 + t2 * (1.0 / 40320 + t2 * (-1.0 / 3628800 + t2 * (1.0 / 479001600.0 + t2 * (-1.0 / 87178291200.0)))))));
            const int qi = ((int)q) & 3;
            const double c = qi == 0 ? cs : (qi == 1 ? -sn : (qi == 2 ? -cs : sn));
            const double s = qi == 0 ? sn : (qi == 1 ? cs : (qi == 2 ? -sn : -cs));
            cosT[i] = (float)c; sinT[i] = (float)s;
        }
    }
    {
        bf16* WS = (bf16*)(F.ws + WS_WS);
        for (int i = F.vcu * 512 + tid; i < 2 * 4 * 128 * 128; i += F.G * 512) { const int s = i & 127, t = (i >> 7) & 127; WS[i] = (s <= t) ? f2bf(AIN(I_GWS)[i]) : (bf16)0; }
        if (F.vcu == 0 && tid < 2) { float mq = 0.f, mk = 0.f;
#pragma unroll 1
            for (int d = 0; d < QKD; ++d) { mq = fmaxf(mq, fabsf(AIN(I_QNG)[tid * QKD + d])); mk = fmaxf(mk, fabsf(AIN(I_KNG)[tid * QKD + d])); }
            ((float*)(F.ws + WS_SMB))[tid] = 96.f * QSCALE * mq * mk * 1.03f + 0.25f; }
        bf16* WRT = (bf16*)(F.ws + WS_WR);
        for (int i = F.vcu * 512 + tid; i < 2 * 64 * 1024; i += F.G * 512) { const int l = i >> 16, r = i & 65535, e = r & 63, k = r >> 6;
            const float v = AIN(I_WR)[(size_t)l * 65536 + (size_t)k * 64 + e]; const unsigned short hi = f2bf(v), lo = f2bf(v - bf2f(hi));
            const size_t pos = ((size_t)((((k >> 7) * 8 + ((k >> 4) & 7)) * 2 + (e >> 5)) * 2) * 64 + ((k >> 3) & 1) * 32 + (e & 31)) * 8 + (k & 7);
            WRT[(size_t)l * 131072 + pos] = hi; WRT[(size_t)l * 131072 + pos + 512] = lo; }
        bf16* WIN = (bf16*)(F.ws + WS_WIN);
        for (int i = F.vcu * 512 + tid; i < 2 * 96 * 1024 / 8; i += F.G * 512) { const int l = i / (96 * 128), r = i % (96 * 128);
            *(u32x4*)(WIN + ((size_t)l * INP + INC) * 1024 + (size_t)r * 8) = (u32x4){0u, 0u, 0u, 0u}; }
    }
    __syncthreads();
    {
        LAS float* scr = (LAS float*)(F.lds + wave * 16384);
        const int gw = F.vcu * 8 + wave, NGW = F.G * 8;
        constexpr int N_IN = 16 * 53, N_Q = 6 * 24, N_KV = 4 * 32, N_OUT = 16 * 32, PER_L = N_IN + N_Q + N_KV + N_OUT;
        for (int it = gw; it < 2 * PER_L; it += NGW) {
            const int l = it / PER_L; int r = it % PER_L;
            if (r < N_IN) { const int kb = r / 53, nb = r % 53;
                tr_item(AIN(I_WIN) + (size_t)l * 1024 * INC, INC, (bf16*)(F.ws + WS_WIN) + (size_t)l * INP * 1024, 1024, nullptr, kb * 64, nb * 32, nb * 32, kb * 64, scr, lane, 0, 0); continue; }
            r -= N_IN;
            if (r < N_Q) { const int kb = r / 24, nb = r % 24;
                tr_item(AIN(I_WQUP) + (size_t)l * QL * 768, 768, (bf16*)(F.ws + WS_WQ) + (size_t)l * 768 * QL, QL, AIN(I_QAG) + l * QL, kb * 64, nb * 32, nb * 32, kb * 64, scr, lane, 0, 0); continue; }
            r -= N_Q;
            if (r < N_KV) { const int kb = r / 32, nb = r % 32;
                tr_item(AIN(I_WKVUP) + (size_t)l * KVL * 1024, 1024, (bf16*)(F.ws + WS_WKV) + (size_t)l * 1024 * KVL, KVL, AIN(I_KVAG) + l * KVL, kb * 64, nb * 32, nb * 32, kb * 64, scr, lane, 0, 0); continue; }
            r -= N_KV;
            if (r < N_OUT) { const int kb = r / 32, nb = r % 32;
                tr_item(AIN(I_WOUT) + (size_t)l * 1024 * 1024, 1024, (bf16*)(F.ws + WS_WOUT) + (size_t)l * 1024 * 1024, 1024, AIN(I_ONG) + l * 1024, kb * 64, nb * 32, nb * 32, (kb * 64 + 512) & 1023, scr, lane, 0, 0); continue; }
        }
    }
    conv_experts(F, 0, 0, CONV_ITEMS, F.vcu, F.G);
}

DI void norm_row_store(const f32x4 (&v)[4], float rinv, const float* gw, const float* sc, const float* sh, bf16* orow, int lane) {
#pragma unroll
    for (int j = 0; j < 4; ++j) { const int c = 4 * lane + 256 * j;
        const f32x4 g = *(const f32x4*)(gw + c), s = *(const f32x4*)(sc + c), h = *(const f32x4*)(sh + c);
        const f32x4 o = v[j] * rinv * (g * (1.f + s)) + h;
        u32x2 w; w.x = pk2(o[0], o[1]); w.y = pk2(o[2], o[3]);
        *(u32x2*)(orow + c) = w; }
}
DI void norm1_phase(const Frame& F0, int l) {
    const Frame F = launder(F0); KArgs& a = *F.ka; l = launder_s(l);
    const float* X = AIN(I_X);
    const int gw = F.vcu * 8 + F.wave, NGW = F.G * 8;
    const float* mod = (const float*)(F.ws + WS_MOD) + (size_t)l * 8 * 6144;
    bf16* H = (bf16*)(F.ws + WS_H);
    for (int m0 = gw; m0 < NTOK; m0 += 2 * NGW) {
        const int m1 = m0 + NGW;
        f32x4 v0[4], v1[4]; float s0 = 0.f, s1 = 0.f;
#pragma unroll
        for (int j = 0; j < 4; ++j) v0[j] = *(const f32x4*)(X + (size_t)m0 * DM + 4 * F.lane + 256 * j);
        if (m1 < NTOK) {
#pragma unroll
            for (int j = 0; j < 4; ++j) v1[j] = *(const f32x4*)(X + (size_t)m1 * DM + 4 * F.lane + 256 * j); }
#pragma unroll
        for (int j = 0; j < 4; ++j) s0 += (v0[j].x * v0[j].x + v0[j].y * v0[j].y) + (v0[j].z * v0[j].z + v0[j].w * v0[j].w);
        { const float rinv = rsqrtf(wave_sum(s0, F.lane) * (1.f / DM) + EPS); const int b = m0 >> 12;
          norm_row_store(v0, rinv, AIN(I_NMG) + l * DM, mod + b * 6144 + 1024, mod + b * 6144, H + (size_t)m0 * DM, F.lane); }
        if (m1 < NTOK) {
#pragma unroll
            for (int j = 0; j < 4; ++j) s1 += (v1[j].x * v1[j].x + v1[j].y * v1[j].y) + (v1[j].z * v1[j].z + v1[j].w * v1[j].w);
            const float rinv = rsqrtf(wave_sum(s1, F.lane) * (1.f / DM) + EPS); const int b = m1 >> 12;
            norm_row_store(v1, rinv, AIN(I_NMG) + l * DM, mod + b * 6144 + 1024, mod + b * 6144, H + (size_t)m1 * DM, F.lane); }
    }
}

DI void mla_prep_unit(const Frame& F0, int l, int unit) {
    const Frame F = launder(F0); KArgs& a = *F.ka; l = launder_s(l);
    const int pmode = a.probe;
    const int lane = F.lane, w = F.wave, tid = F.tid, j31 = lane & 31, hf = lane >> 5;
    const int tile = unit >> 1, part = unit & 1;
    const int tok = tile * 256 + 32 * w + j31, b = (tile * 256) >> 12, s = tok & 4095;
    const bf16* LAT = (const bf16*)(F.ws + WS_LAT);
    const float* cosT = (const float*)(F.ws + WS_COS) + (size_t)tok * 16; const float* sinT = (const float*)(F.ws + WS_SIN) + (size_t)tok * 16;
    f32x4 cs[2], sn[2];
#pragma unroll
    for (int g = 0; g < 2; ++g) { cs[g] = *(const f32x4*)(cosT + 4 * hf + 8 * g); sn[g] = *(const f32x4*)(sinT + 4 * hf + 8 * g); }
    LAS unsigned char* wl = F.lds;
    if (part == 0) {
        const bf16* lrow = LAT + (size_t)tok * LATW + 8 * hf;
        bf16x8 bq[24]; float ss = 0.f;
#pragma unroll
        for (int ks = 0; ks < 24; ++ks) { bq[ks] = *(const bf16x8*)(lrow + 16 * ks);
#pragma unroll
            for (int q = 0; q < 8; ++q) { const float v = bf2f((unsigned short)bq[ks][q]); ss += v * v; } }
        ss += shx(ss, 32, lane);
        const float rq = rsqrtf(ss * (1.f / QL) + EPS);
        const bf16* WQ = (const bf16*)(F.ws + WS_WQ) + (size_t)l * 768 * QL;
        LAS float* gnl = (LAS float*)(F.lds + 130048);
        if (tid < QKD) gnl[tid] = AIN(I_QNG)[l * QKD + tid] * QSCALE;
        bf16* Qb = (bf16*)(F.ws + WS_Q);
        auto dmaq = [&](int hh, int ph) {
            LAS unsigned char* sb = wl + ph * 38400;
            const char* srcw = (const char*)(const GAS bf16*)uniform_ptr(WQ + (size_t)(hh * 96) * QL + ph * 192);
            int ln_ = lane; asm volatile("" : "+v"(ln_));
#pragma unroll
            for (int i = 0; i < 5; ++i) { const int inst = w + 8 * i;
                if (inst < 38) { const int c = inst * 64 + ln_; const int row = (c * 5243) >> 17, cc = c - row * 25;
                    const unsigned off = (unsigned)(row * QL + 8 * (cc > 23 ? 23 : cc)) * 2u;
                    if (c < 2400) __builtin_amdgcn_global_load_lds((const unsigned*)(srcw + off), (LAS unsigned*)(sb + inst * 1024), 16, 0, 0); } }
        };
        __syncthreads();
        dmaq(0, 0); dmaq(0, 1);
        for (int h = 0; h < NH; ++h) {
            f32x16 acc[3];
#pragma unroll
            for (int d = 0; d < 3; ++d) acc[d] = zero16();
            asm volatile("s_waitcnt vmcnt(0)" ::: "memory"); __syncthreads();
#pragma unroll
            for (int ks = 0; ks < 12; ++ks)
#pragma unroll
                for (int db = 0; db < 3; ++db) { const bf16x8 af = *(const LAS bf16x8*)(wl + (32 * db + j31) * 400 + (16 * ks + 8 * hf) * 2); acc[db] = MFMA32(af, bq[ks], acc[db]); if (db == 2 && (ks & 1)) asm volatile("" ::: "memory"); }
            __syncthreads();
            if (h + 1 < NH) dmaq(h + 1, 0);
#pragma unroll
            for (int ks = 0; ks < 12; ++ks)
#pragma unroll
                for (int db = 0; db < 3; ++db) { const bf16x8 af = *(const LAS bf16x8*)(wl + 38400 + (32 * db + j31) * 400 + (16 * ks + 8 * hf) * 2); acc[db] = MFMA32(af, bq[12 + ks], acc[db]); if (db == 2 && (ks & 1)) asm volatile("" ::: "memory"); }
            __syncthreads();
            if (h + 1 < NH) dmaq(h + 1, 1);
            float hs = 0.f;
#pragma unroll
            for (int db = 0; db < 3; ++db)
#pragma unroll
                for (int i = 0; i < 16; ++i) { acc[db][i] *= rq; hs += acc[db][i] * acc[db][i]; }
            hs += shx(hs, 32, lane);
            const float rn = rsqrtf(hs * (1.f / QKD) + EPS) ;
#pragma unroll
            for (int db = 0; db < 3; ++db)
#pragma unroll
                for (int g = 0; g < 4; ++g) { const f32x4 gn = *(const LAS f32x4*)(gnl + 32 * db + 4 * hf + 8 * g);
#pragma unroll
                    for (int r = 0; r < 4; ++r) acc[db][4 * g + r] *= rn * gn[r]; }
#pragma unroll
            for (int g = 0; g < 2; ++g)
#pragma unroll
                for (int r = 0; r < 4; ++r) { const float x1 = acc[2][4 * g + r], x2 = acc[2][4 * (g + 2) + r];
                    acc[2][4 * g + r] = x1 * cs[g][r] - x2 * sn[g][r]; acc[2][4 * (g + 2) + r] = x1 * sn[g][r] + x2 * cs[g][r]; }
            LAS unsigned char* tw = F.lds + 76800 + w * 6656;
#pragma unroll
            for (int db = 0; db < 3; ++db)
#pragma unroll
                for (int g = 0; g < 4; ++g) { u32x2 o; o.x = pk2(acc[db][4 * g], acc[db][4 * g + 1]); o.y = pk2(acc[db][4 * g + 2], acc[db][4 * g + 3]);
                    *(LAS u32x2*)(tw + j31 * 208 + (32 * db + 4 * hf + 8 * g) * 2) = o; }
            { bf16* qtile = Qb + ((size_t)(b * NH + h) * SEQ + (s - j31)) * QKD;
              int ln_ = lane; asm volatile("" : "+v"(ln_));
#pragma unroll
              for (int r = 0; r < 6; ++r) { const int c = ln_ + 64 * r, row = c / 12, part = c % 12;
                  const u32x4 v = *(const LAS u32x4*)(tw + row * 208 + part * 16);
                  if (pmode != 12) *(u32x4*)(qtile + (size_t)c * 8) = v; } }
        }
    } else {
        const bf16* lrow = LAT + (size_t)tok * LATW + QL + 8 * hf;
        bf16x8 bk[16]; float ss = 0.f;
#pragma unroll
        for (int ks = 0; ks < 16; ++ks) { bk[ks] = *(const bf16x8*)(lrow + 16 * ks);
#pragma unroll
            for (int q = 0; q < 8; ++q) { const float v = bf2f((unsigned short)bk[ks][q]); ss += v * v; } }
        ss += shx(ss, 32, lane);
        const float rkv = rsqrtf(ss * (1.f / KVL) + EPS);
        float pe[16]; float pss = 0.f;
#pragma unroll
        for (int g = 0; g < 4; ++g) { const u32x2 raw = *(const u32x2*)(LAT + (size_t)tok * LATW + 640 + 4 * hf + 8 * g);
            pe[4 * g] = bflo(raw.x); pe[4 * g + 1] = bfhi(raw.x); pe[4 * g + 2] = bflo(raw.y); pe[4 * g + 3] = bfhi(raw.y); }
#pragma unroll
        for (int i = 0; i < 16; ++i) pss += pe[i] * pe[i];
        const bf16* WKV = (const bf16*)(F.ws + WS_WKV) + (size_t)l * 1024 * KVL;
        LAS float* kng = (LAS float*)(F.lds + 130048);
        if (tid < QKD) kng[tid] = AIN(I_KNG)[l * QKD + tid];
        bf16* Kb = (bf16*)(F.ws + WS_K); bf16* Vt = (bf16*)(F.ws + WS_VT);
        auto dmak = [&](int hh, int ph) {
            LAS unsigned char* sb = wl + ph * 34816;
            const char* srcw = (const char*)(const GAS bf16*)uniform_ptr(WKV + (size_t)(hh * 128) * KVL + ph * 128);
            int ln_ = lane; asm volatile("" : "+v"(ln_));
#pragma unroll
            for (int i = 0; i < 5; ++i) { const int inst = w + 8 * i;
                if (inst < 34) { const int c = inst * 64 + ln_; const int row = (c * 3856) >> 16, cc = c - row * 17;
                    const unsigned off = (unsigned)(row * KVL + 8 * (cc > 15 ? 15 : cc)) * 2u;
                    __builtin_amdgcn_global_load_lds((const unsigned*)(srcw + off), (LAS unsigned*)(sb + inst * 1024), 16, 0, 0); } }
        };
        __syncthreads();
        dmak(0, 0); dmak(0, 1);
        for (int h = 0; h < NH; ++h) {
            f32x16 acc[4];
#pragma unroll
            for (int d = 0; d < 4; ++d) acc[d] = zero16();
            asm volatile("s_waitcnt vmcnt(0)" ::: "memory"); __syncthreads();
#pragma unroll
            for (int ks = 0; ks < 8; ++ks)
#pragma unroll
                for (int db = 0; db < 4; ++db) { const bf16x8 af = *(const LAS bf16x8*)(wl + (32 * db + j31) * 272 + (16 * ks + 8 * hf) * 2); acc[db] = MFMA32(af, bk[ks], acc[db]); if (db == 3 && (ks & 1)) asm volatile("" ::: "memory"); }
            __syncthreads();
            if (h + 1 < NH) dmak(h + 1, 0);
#pragma unroll
            for (int ks = 0; ks < 8; ++ks)
#pragma unroll
                for (int db = 0; db < 4; ++db) { const bf16x8 af = *(const LAS bf16x8*)(wl + 34816 + (32 * db + j31) * 272 + (16 * ks + 8 * hf) * 2); acc[db] = MFMA32(af, bk[8 + ks], acc[db]); if (db == 3 && (ks & 1)) asm volatile("" ::: "memory"); }
            __syncthreads();
            if (h + 1 < NH) dmak(h + 1, 1);
            float hs = pss;
#pragma unroll
            for (int db = 0; db < 2; ++db)
#pragma unroll
                for (int i = 0; i < 16; ++i) { acc[db][i] *= rkv; hs += acc[db][i] * acc[db][i]; }
            hs += shx(hs, 32, lane);
            const float rn = rsqrtf(hs * (1.f / QKD) + EPS);
            LAS unsigned char* tw = F.lds + 76800 + w * 6656;
#pragma unroll
            for (int db = 0; db < 2; ++db)
#pragma unroll
                for (int g = 0; g < 4; ++g) { const f32x4 gn = *(const LAS f32x4*)(kng + 32 * db + 4 * hf + 8 * g);
                    u32x2 o; o.x = pk2(acc[db][4 * g] * rn * gn[0], acc[db][4 * g + 1] * rn * gn[1]); o.y = pk2(acc[db][4 * g + 2] * rn * gn[2], acc[db][4 * g + 3] * rn * gn[3]);
                    *(LAS u32x2*)(tw + j31 * 208 + (32 * db + 4 * hf + 8 * g) * 2) = o; }
            float kp[16];
#pragma unroll
            for (int g = 0; g < 4; ++g) { const f32x4 gn = *(const LAS f32x4*)(kng + 64 + 4 * hf + 8 * g);
#pragma unroll
                for (int r = 0; r < 4; ++r) kp[4 * g + r] = pe[4 * g + r] * rn * gn[r]; }
#pragma unroll
            for (int g = 0; g < 2; ++g)
#pragma unroll
                for (int r = 0; r < 4; ++r) { const float x1 = kp[4 * g + r], x2 = kp[4 * (g + 2) + r];
                    kp[4 * g + r] = x1 * cs[g][r] - x2 * sn[g][r]; kp[4 * (g + 2) + r] = x1 * sn[g][r] + x2 * cs[g][r]; }
#pragma unroll
            for (int g = 0; g < 4; ++g) { u32x2 o; o.x = pk2(kp[4 * g], kp[4 * g + 1]); o.y = pk2(kp[4 * g + 2], kp[4 * g + 3]); *(LAS u32x2*)(tw + j31 * 208 + (64 + 4 * hf + 8 * g) * 2) = o; }
            { bf16* ktile = Kb + ((size_t)(b * NH + h) * SEQ + (s - j31)) * QKD;
              int ln_ = lane; asm volatile("" : "+v"(ln_));
#pragma unroll
              for (int r = 0; r < 6; ++r) { const int c = ln_ + 64 * r, row = c / 12, part = c % 12;
                  const u32x4 v = *(const LAS u32x4*)(tw + row * 208 + part * 16);
                  if (pmode != 12) *(u32x4*)(ktile + (size_t)c * 8) = v; } }
            bf16* vb_u = Vt + ((size_t)(b * NH + h) * VD) * SEQ;
            const int sp = (s & ~12) | ((s & 8) >> 1) | ((s & 4) << 1);
            const unsigned vlo = (unsigned)(4 * hf * SEQ + sp);
#pragma unroll
            for (int db = 0; db < 2; ++db)
#pragma unroll
                for (int i = 0; i < 16; ++i) { bf16* up = vb_u + (size_t)(32 * db + 8 * (i >> 2) + (i & 3)) * SEQ; if (pmode != 11 && pmode != 12) up[vlo] = f2bf(acc[2 + db][i] * rkv); }
        }
    }
    __syncthreads();
}

DI void gmlp_unit(const Frame& F0, int l, int unit) {
    const Frame F = launder(F0); KArgs& a = *F.ka; l = launder_s(l);
    const int lane = F.lane, w = F.wave, tid = F.tid, j31 = lane & 31, hf = lane >> 5;
    const int t0 = unit * 128;
    const bf16* UV = (const bf16*)(F.ws + WS_UV);
    bf16* MIX = (bf16*)(F.ws + WS_MIX);
    const bf16* WSb = (const bf16*)(F.ws + WS_WS) + (size_t)l * 4 * 128 * 128;
    LAS unsigned char* lv = F.lds;
    LAS float* red = (LAS float*)(F.lds + 36864);
    const int tb = w & 3, cb0 = (w >> 2) * 2;
    float ssq = 0.f;
    u32x4 vraw[4];
    { const bf16* vp0 = UV + (size_t)(t0 + (tid >> 2)) * DM + 512 + 32 * (tid & 3);
#pragma unroll
      for (int q = 0; q < 4; ++q) vraw[q] = *(const u32x4*)(vp0 + 8 * q); }
    for (int g = 0; g < 4; ++g) {
        {
            const int s = tid >> 2, cp = tid & 3;
            float x[32];
#pragma unroll
            for (int q = 0; q < 4; ++q) { const u32x4 raw = vraw[q];
#pragma unroll
                for (int e = 0; e < 4; ++e) { x[8 * q + 2 * e] = bflo(raw[e]); x[8 * q + 2 * e + 1] = bfhi(raw[e]); } }
            float sm = 0.f;
#pragma unroll
            for (int i = 0; i < 32; ++i) sm += x[i];
            sm += shx(sm, 1, lane); sm += shx(sm, 2, lane);
            const float mu = sm * (1.f / 128.f);
            float vq = 0.f;
#pragma unroll
            for (int i = 0; i < 32; ++i) { x[i] -= mu; vq += x[i] * x[i]; }
            vq += shx(vq, 1, lane); vq += shx(vq, 2, lane);
            const float rstd = rsqrtf(vq * (1.f / 128.f) + EPS);
            const float* lg = AIN(I_LNG) + (l * 4 + g) * 128 + 32 * cp; const float* lb = AIN(I_LNB) + (l * 4 + g) * 128 + 32 * cp;
#pragma unroll
            for (int i = 0; i < 32; ++i) { const float y = x[i] * rstd * lg[i] + lb[i]; *(LAS bf16*)(lv + (32 * cp + i) * 272 + s * 2) = f2bf(y); }
        }
        const int t = 32 * tb + j31;
        const bf16* up = UV + (size_t)(t0 + t) * DM + 128 * g + 32 * cb0 + 4 * hf;
        u32x2 ur_[2][4];
#pragma unroll
        for (int ci = 0; ci < 2; ++ci)
#pragma unroll
            for (int q = 0; q < 4; ++q) ur_[ci][q] = *(const u32x2*)(up + 32 * ci + 8 * q);
        if (g < 3) { const bf16* vpn = UV + (size_t)(t0 + (tid >> 2)) * DM + 512 + 128 * (g + 1) + 32 * (tid & 3);
#pragma unroll
            for (int q = 0; q < 4; ++q) vraw[q] = *(const u32x4*)(vpn + 8 * q); }
        __syncthreads();
        f32x16 acc[2]; acc[0] = zero16(); acc[1] = zero16();
        const bf16* wrow = WSb + ((size_t)g * 128 + 32 * tb + j31) * 128 + 8 * hf;
#pragma unroll
        for (int ks = 0; ks < 8; ++ks) {
            if (ks < 2 * (tb + 1)) {
                const bf16x8 bfr = *(const bf16x8*)(wrow + 16 * ks);
#pragma unroll
                for (int ci = 0; ci < 2; ++ci) { const bf16x8 af = *(const LAS bf16x8*)(lv + (32 * (cb0 + ci) + j31) * 272 + (16 * ks + 8 * hf) * 2); acc[ci] = MFMA32(af, bfr, acc[ci]); }
            }
        }
        const float bsv = AIN(I_GBS)[(l * 4 + g) * 128 + t];
        bf16* op = MIX + (size_t)(t0 + t) * DM + 512 + 128 * g + 32 * cb0 + 4 * hf;
#pragma unroll
        for (int ci = 0; ci < 2; ++ci)
#pragma unroll
            for (int q = 0; q < 4; ++q) { const u32x2 ur = ur_[ci][q];
                const float u0 = bflo(ur.x), u1 = bfhi(ur.x), u2 = bflo(ur.y), u3 = bfhi(ur.y);
                const float o0 = u0 * (acc[ci][4 * q] + bsv), o1 = u1 * (acc[ci][4 * q + 1] + bsv), o2 = u2 * (acc[ci][4 * q + 2] + bsv), o3 = u3 * (acc[ci][4 * q + 3] + bsv);
                ssq += (o0 * o0 + o1 * o1) + (o2 * o2 + o3 * o3);
                u32x2 ov; ov.x = pk2(o0, o1); ov.y = pk2(o2, o3); *(u32x2*)(op + 32 * ci + 8 * q) = ov; }
        __syncthreads();
    }
    ssq += shx(ssq, 32, lane);
    if (hf == 0) red[(w >> 2) * 128 + 32 * tb + j31] = ssq;
    __syncthreads();
    if (tid < 128) { const float v = red[tid] + red[128 + tid]; ((float*)(F.ws + WS_RGM))[t0 + tid] = rsqrtf(v * (1.f / 512.f) + EPS); }
    __syncthreads();
}

constexpr int AK_STRIDE = 208, AV_STRIDE = 144, AK_BYTES = 64 * AK_STRIDE, AV_BYTES = 64 * AV_STRIDE, ASLOT = AK_BYTES + AV_BYTES;
DI void attn_unit(const Frame& F0, int l, int b, int h, int qt) {
    const Frame F = launder(F0);
    const float nM = -((const float*)(F.ws + WS_SMB))[l];
    const int lane = F.lane, w = F.wave, tid = F.tid, j31 = lane & 31, hf = lane >> 5;
    const int bh = b * NH + h;
    const bf16* Qb = (const bf16*)(F.ws + WS_Q) + (size_t)bh * SEQ * QKD;
    const bf16* Kb = (const bf16*)(F.ws + WS_K) + (size_t)bh * SEQ * QKD;
    const bf16* Vt = (const bf16*)(F.ws + WS_VT) + (size_t)bh * VD * SEQ;
    const int qw = qt * 512 + 64 * w, cq = qt * 8 + w, ntiles = qt * 8 + 8;
    bf16x8 bq[2][6];
#pragma unroll
    for (int qb = 0; qb < 2; ++qb)
#pragma unroll
        for (int ds = 0; ds < 6; ++ds) bq[qb][ds] = *(const bf16x8*)(Qb + (size_t)(qw + 32 * qb + j31) * QKD + 16 * ds + 8 * hf);
    f32x16 O[2][2];
#pragma unroll
    for (int x = 0; x < 2; ++x)
#pragma unroll
        for (int y = 0; y < 2; ++y) O[x][y] = zero16();
    float lrun[2] = {0.f, 0.f};
    unsigned ko0, ko1, vo0, vo1;
    { const int c0 = tid, c1 = tid + 512; int r, p;
      r = c0 / 13; p = c0 % 13; ko0 = (unsigned)(r * QKD + 8 * (p > 11 ? 11 : p));
      r = c1 / 13; p = c1 % 13; if (r > 63) r = 63; ko1 = (unsigned)(r * QKD + 8 * (p > 11 ? 11 : p));
      r = c0 / 9; p = c0 % 9; vo0 = (unsigned)(r * SEQ + 8 * (p > 7 ? 7 : p));
      r = c1 / 9; p = c1 % 9; if (r > 63) r = 63; vo1 = (unsigned)(r * SEQ + 8 * (p > 7 ? 7 : p)); }
    auto dma = [&](int t, int slot) {
        LAS unsigned char* sb = F.lds + slot * ASLOT;
        const bf16* kt = Kb + (size_t)(64 * t) * QKD; const bf16* vt = Vt + 64 * t;
        __builtin_amdgcn_global_load_lds((const unsigned*)(kt + ko0), (LAS unsigned*)(sb + w * 1024), 16, 0, 0);
        if (w < 5) __builtin_amdgcn_global_load_lds((const unsigned*)(kt + ko1), (LAS unsigned*)(sb + 8192 + w * 1024), 16, 0, 0);
        __builtin_amdgcn_global_load_lds((const unsigned*)(vt + vo0), (LAS unsigned*)(sb + AK_BYTES + w * 1024), 16, 0, 0);
        if (w == 0) __builtin_amdgcn_global_load_lds((const unsigned*)(vt + vo1), (LAS unsigned*)(sb + AK_BYTES + 8192), 16, 0, 0);
    };
    __syncthreads();
    dma(0, 0);
    asm volatile("s_waitcnt vmcnt(0)" ::: "memory");
    __syncthreads();
    for (int t = 0; t < ntiles; ++t) {
        if (t + 1 < ntiles) dma(t + 1, (t + 1) & 1);
        if (t <= cq) {
            const LAS unsigned char* kb_ = F.lds + (t & 1) * ASLOT; const LAS unsigned char* vb_ = kb_ + AK_BYTES;
#pragma unroll
            for (int qb = 0; qb < 2; ++qb) {
                f32x16 S[2];
#pragma unroll
                for (int i = 0; i < 16; ++i) { S[0][i] = nM; S[1][i] = nM; }
#pragma unroll
                for (int ds = 0; ds < 6; ++ds)
#pragma unroll
                    for (int kb = 0; kb < 2; ++kb) { const bf16x8 af = *(const LAS bf16x8*)(kb_ + (32 * kb + j31) * AK_STRIDE + (16 * ds + 8 * hf) * 2);
                        S[kb] = MFMA32(af, bq[qb][ds], S[kb]); }
                float rs = 0.f;
                bf16x8 pf[2][2];
#pragma unroll
                for (int kb = 0; kb < 2; ++kb)
#pragma unroll
                    for (int s = 0; s < 2; ++s) { u32x4 p4;
#pragma unroll
                        for (int e = 0; e < 4; ++e) { const float p0 = __builtin_amdgcn_exp2f(S[kb][8 * s + 2 * e]), p1 = __builtin_amdgcn_exp2f(S[kb][8 * s + 2 * e + 1]);
                            rs += p0 + p1; p4[e] = pk2(p0, p1); }
                        pf[kb][s] = __builtin_bit_cast(bf16x8, p4); }
                lrun[qb] += rs;
#pragma unroll
                for (int kb = 0; kb < 2; ++kb)
#pragma unroll
                    for (int s = 0; s < 2; ++s) {
#pragma unroll
                        for (int db = 0; db < 2; ++db) {
                            const bf16x8 af = *(const LAS bf16x8*)(vb_ + (32 * db + j31) * AV_STRIDE + (32 * kb + 16 * s + 8 * hf) * 2);
                            O[db][qb] = MFMA32(af, pf[kb][s], O[db][qb]); }
                        if (s == 1) asm volatile("" ::: "memory");
                    }
                __builtin_amdgcn_sched_barrier(0);
            }
        }
        asm volatile("s_waitcnt vmcnt(0)" ::: "memory");
        __syncthreads();
    }
    bf16* MIX = (bf16*)(F.ws + WS_MIX); float* SSQ = (float*)(F.ws + WS_SSQ);
#pragma unroll
    for (int qb = 0; qb < 2; ++qb) {
        const float lt = lrun[qb] + shx(lrun[qb], 32, lane);
        const float inv = 1.f / lt;
        const int tok = b * SEQ + qw + 32 * qb + j31;
        float ss = 0.f;
#pragma unroll
        for (int db = 0; db < 2; ++db)
#pragma unroll
            for (int g = 0; g < 4; ++g) { float o[4];
#pragma unroll
                for (int r = 0; r < 4; ++r) { o[r] = O[db][qb][4 * g + r] * inv; ss += o[r] * o[r]; }
                u32x2 pk; pk.x = pk2(o[0], o[1]); pk.y = pk2(o[2], o[3]);
                *(u32x2*)(MIX + (size_t)tok * DM + h * VD + 32 * db + 4 * hf + 8 * g) = pk; }
        ss += shx(ss, 32, lane);
        if (hf == 0) SSQ[(size_t)tok * 8 + h] = ss;
    }
}
DI void attn_phase(const Frame& F, int l) {
    for (int p = F.vcu; p < 256; p += F.G) {
        const int bh = p >> 2, j = p & 3;
#pragma unroll 1
        for (int k = 0; k < 2; ++k) attn_unit(F, l, bh >> 3, bh & 7, k ? j : 7 - j);
    }
}

struct EpiIn {
    static constexpr bool PERM = true, MID = false; static constexpr int HROWS = 128;
    static DI int bsrc(int R) { return (R & ~31) + pg8::perm32(R & 31); }
    bf16* UV; bf16* LAT;
    static constexpr int NST = 16, NPRE = 0;
    DI void prefetch(const pg8::Unit&, LAS unsigned char*, int, int) const {}
    DI void mid(f32x4 (&)[2][2][4][2], const pg8::Unit&, int, int) const {}
    DI void operator()(const f32x4 (&acc)[2][2][4][2], LAS unsigned char*, const pg8::Unit& u, int wr, int wc, int fr, int fq) const {
        const int row0 = u.pm * 256 + wr * 64 + fr;
        const bool act = u.pn < 4;
        bf16* base = act ? UV : LAT; const int ldc = act ? DM : LATW; const int col0 = (act ? u.pn : u.pn - 4) * 256 + wc * 32 + 8 * fq;
#pragma unroll
        for (int ai = 0; ai < 2; ++ai)
#pragma unroll
            for (int m = 0; m < 4; ++m) { bf16* rowp = base + (size_t)(row0 + ai * 128 + m * 16) * ldc + col0;
#pragma unroll
                for (int bj = 0; bj < 2; ++bj) { f32x4 v0 = acc[ai][bj][m][0], v1 = acc[ai][bj][m][1];
                    if (act) { const f32x2 a_ = pg8::gelu_pk((f32x2){v0[0], v0[1]}), b_ = pg8::gelu_pk((f32x2){v0[2], v0[3]}), c_ = pg8::gelu_pk((f32x2){v1[0], v1[1]}), d_ = pg8::gelu_pk((f32x2){v1[2], v1[3]});
                        v0 = (f32x4){a_.x, a_.y, b_.x, b_.y}; v1 = (f32x4){c_.x, c_.y, d_.x, d_.y}; }
                    u32x4 wv; wv.x = pk2(v0[0], v0[1]); wv.y = pk2(v0[2], v0[3]); wv.z = pk2(v1[0], v1[1]); wv.w = pk2(v1[2], v1[3]);
                    *(u32x4*)(rowp + bj * 128) = wv; } }
    }
};
struct EpiOut {
    static constexpr bool PERM = true, MID = (OUT_MID != 0); static constexpr int HROWS = 128;
    static DI int bsrc(int R) { return (R & ~31) + pg8::perm32(R & 31); }
    const float* xin32; const bf16* xin16; bf16* xout; const float* g1; const LAS float* tab;
    static constexpr int NST = -1, NPRE = 0;
    DI void prefetch(const pg8::Unit&, LAS unsigned char*, int, int) const {}
    DI void mid(f32x4 (&acc)[2][2][4][2], const pg8::Unit& u, int wr, int fr) const {
#pragma unroll
        for (int ai = 0; ai < 2; ++ai)
#pragma unroll
            for (int m = 0; m < 4; ++m) { const float sc = tab[u.e * 512 + ai * 128 + wr * 64 + m * 16 + fr];
#pragma unroll
                for (int bj = 0; bj < 2; ++bj)
#pragma unroll
                    for (int n = 0; n < 2; ++n) acc[ai][bj][m][n] = acc[ai][bj][m][n] * sc; }
    }
    DI void operator()(const f32x4 (&acc)[2][2][4][2], LAS unsigned char*, const pg8::Unit& u, int wr, int wc, int fr, int fq) const {
        const int row0 = u.pm * 256 + wr * 64 + fr, col0 = u.pn * 256 + wc * 32 + 8 * fq;
        const float* gb = g1 + (size_t)(row0 >> 12) * 6144 + col0;
        f32x4 gv[2][2];
#pragma unroll
        for (int bj = 0; bj < 2; ++bj)
#pragma unroll
            for (int n = 0; n < 2; ++n) gv[bj][n] = *(const f32x4*)(gb + bj * 128 + n * 4);
        const LAS float* tp = tab + u.e * 512 + 256 + wr * 64 + fr;
#pragma unroll
        for (int ai = 0; ai < 2; ++ai)
#pragma unroll
            for (int m = 0; m < 4; ++m) { const float rg = tp[ai * 128 + m * 16]; const size_t off = (size_t)(row0 + ai * 128 + m * 16) * DM + col0;
#pragma unroll
                for (int bj = 0; bj < 2; ++bj) { f32x4 x0, x1;
                    if (xin32) { x0 = *(const f32x4*)(xin32 + off + bj * 128); x1 = *(const f32x4*)(xin32 + off + bj * 128 + 4); }
                    else { const u32x4 r = *(const u32x4*)(xin16 + off + bj * 128); x0 = (f32x4){bflo(r.x), bfhi(r.x), bflo(r.y), bfhi(r.y)}; x1 = (f32x4){bflo(r.z), bfhi(r.z), bflo(r.w), bfhi(r.w)}; }
                    const f32x4 o0 = x0 + gv[bj][0] * (acc[ai][bj][m][0] * rg), o1 = x1 + gv[bj][1] * (acc[ai][bj][m][1] * rg);
                    u32x4 wv; wv.x = pk2(o0[0], o0[1]); wv.y = pk2(o0[2], o0[3]); wv.z = pk2(o1[0], o1[1]); wv.w = pk2(o1[2], o1[3]);
                    *(u32x4*)(xout + off + bj * 128) = wv; } }
    }
};
DI void outproj_tables(const Frame& F0, const pg8::DenseSched& S) {
    const Frame F = launder(F0);
    LAS float* tab = (LAS float*)(F.lds + LDSCTL_OFF + LC_UTAB);
    const float* ssq = (const float*)(F.ws + WS_SSQ); const float* rgm = (const float*)(F.ws + WS_RGM);
    pg8::Unit u;
#pragma unroll 1
    for (int i = 0; i < 7 && S.next(i, u); ++i) {
        if (F.tid < 256) { const int row = u.pm * 256 + F.tid;
            const f32x4 s0 = *(const f32x4*)(ssq + (size_t)row * 8), s1 = *(const f32x4*)(ssq + (size_t)row * 8 + 4);
            const float tot = ((s0[0] + s0[1]) + (s0[2] + s0[3])) + ((s1[0] + s1[1]) + (s1[2] + s1[3]));
            const float rg = rgm[row];
            tab[i * 512 + F.tid] = rsqrtf(tot * (1.f / 512.f) + EPS) / rg; tab[i * 512 + 256 + F.tid] = rg; }
    }
    __syncthreads();
}
template <bool GATHER>
struct MoeSched {
    static constexpr int NDMA = GATHER ? 1 : 0;
    const LAS u32x4* utab; int nmy; const u32x2* list; int half;
    DI bool next(int i, pg8::Unit& u) const { if (i >= nmy) return false; const u32x4 v = utab[i];
        const int vx = __builtin_amdgcn_readfirstlane((int)v.x), vy = __builtin_amdgcn_readfirstlane((int)v.y), vz = __builtin_amdgcn_readfirstlane((int)v.z), vw = __builtin_amdgcn_readfirstlane((int)v.w);
        u.pm = vx; u.pn = vy & 0xffff; u.e = (int)((unsigned)vy >> 16); u.p0 = vz; u.cnt = vw; return true; }
    DI void a_offs(const pg8::Unit& u, int tid, int lda, unsigned (&o)[2][2]) const {
#pragma unroll
        for (int i = 0; i < 2; ++i) { int R, C; pg8::stage_rc(tid * 16 + i * 8192, R, C);
#pragma unroll
            for (int h = 0; h < 2; ++h) {
                if (GATHER) { const int p = min(u.p0 + h * 128 + R, u.cnt - 1);
                    const int tok = half * HALFTOK + (int)(list[(size_t)u.e * LCAP + p].x / 9u);
                    o[h][i] = (unsigned)(tok * lda + C) * 2u; }
                else o[h][i] = (unsigned)((u.pm * 256 + h * 128 + R) * lda + C) * 2u;
            } }
    }
    DI void dma_next(const pg8::Unit& u, LAS unsigned char* nx, int wid, int lane) const {
        if constexpr (GATHER) { const int p = min(u.p0 + (wid & 3) * 64 + lane, u.cnt - 1);
            __builtin_amdgcn_global_load_lds((const unsigned*)(list + (size_t)u.e * LCAP + p), (LAS unsigned*)(nx + (wid & 3) * 256), 4, 0, 0); }
    }
    DI void offs_lds(LAS unsigned char* nx, int tid, int lda, unsigned (&o)[2][2]) const {
        if constexpr (GATHER) {
#pragma unroll
        for (int i = 0; i < 2; ++i) { int R, C; pg8::stage_rc(tid * 16 + i * 8192, R, C);
#pragma unroll
            for (int h = 0; h < 2; ++h) { const unsigned x = *(const LAS unsigned*)(nx + (h * 128 + R) * 4);
                o[h][i] = (unsigned)((half * HALFTOK + (int)(x / 9u)) * lda + C) * 2u; } }
        }
    }
    DI size_t b_off(const pg8::Unit& u, int K) const { return GATHER ? ((size_t)u.e * 512 + u.pn * 256) * K * 2 : ((size_t)u.e * 1024 + u.pn * 256) * K * 2; }
};
struct EpiE1 {
    static constexpr bool PERM = true, MID = false; static constexpr int HROWS = 128;
    static DI int bsrc(int R) { return (R & ~31) + pg8::perm32(R & 31); }
    unsigned char* act; const u32x2* list;
    static constexpr int NST = 8, NPRE = 2;
    DI void prefetch(const pg8::Unit& u, LAS unsigned char* pre, int wr, int lane) const {
#pragma unroll
        for (int ai = 0; ai < 2; ++ai) { const int p = min(u.p0 + ai * 128 + wr * 64 + lane, u.cnt - 1);
            __builtin_amdgcn_global_load_lds((const unsigned*)(list + (size_t)u.e * LCAP + p) + 1, (LAS unsigned*)(pre + ai * 256), 4, 0, 0); }
    }
    DI void mid(f32x4 (&)[2][2][4][2], const pg8::Unit&, int, int) const {}
    DI void operator()(const f32x4 (&acc)[2][2][4][2], LAS unsigned char* pre, const pg8::Unit& u, int wr, int wc, int fr, int fq) const {
#pragma unroll
        for (int ai = 0; ai < 2; ++ai)
#pragma unroll
            for (int m = 0; m < 4; ++m) { const int r = ai * 128 + wr * 64 + m * 16 + fr;
                float wgt = *(const LAS float*)(pre + ai * 256 + (m * 16 + fr) * 4); if (u.p0 + r >= u.cnt) wgt = 0.f;
                float o[8];
#pragma unroll
                for (int n = 0; n < 2; ++n)
#pragma unroll
                    for (int j = 0; j < 4; ++j) { const float g = acc[ai][0][m][n][j] * (1.f / 64.f), up = acc[ai][1][m][n][j] * (4.f / 64.f);
                        const float sg = g * __builtin_amdgcn_rcpf(1.f + __builtin_amdgcn_exp2f(-1.4426950408889634f * g));
                        o[4 * n + j] = sg * up * wgt; }
                int p0 = __builtin_amdgcn_cvt_pk_fp8_f32(o[0], o[1], 0, false); p0 = __builtin_amdgcn_cvt_pk_fp8_f32(o[2], o[3], p0, true);
                int p1 = __builtin_amdgcn_cvt_pk_fp8_f32(o[4], o[5], 0, false); p1 = __builtin_amdgcn_cvt_pk_fp8_f32(o[6], o[7], p1, true);
                *(u32x2*)(act + (size_t)(u.pm * 256 + r) * FF + u.pn * 128 + wc * 32 + 8 * fq) = (u32x2){(unsigned)p0, (unsigned)p1}; }
    }
};
struct EpiE2 {
    static constexpr bool PERM = true, MID = false; static constexpr int HROWS = 8;
    static DI int bsrc(int R) { return 64 * ((R >> 5) & 3) + 16 * ((R >> 2) & 3) + 4 * ((R >> 4) & 1) + (R & 3); }
    unsigned char* y; const u32x2* list;
    static constexpr int NST = 8, NPRE = 2;
    DI void prefetch(const pg8::Unit& u, LAS unsigned char* pre, int wr, int lane) const {
#pragma unroll
        for (int ai = 0; ai < 2; ++ai) { const int p = min(u.p0 + ai * 128 + wr * 64 + lane, u.cnt - 1);
            __builtin_amdgcn_global_load_lds((const unsigned*)(list + (size_t)u.e * LCAP + p), (LAS unsigned*)(pre + ai * 256), 4, 0, 0); }
    }
    DI void mid(f32x4 (&)[2][2][4][2], const pg8::Unit&, int, int) const {}
    DI void operator()(const f32x4 (&acc)[2][2][4][2], LAS unsigned char* pre, const pg8::Unit& u, int wr, int wc, int fr, int fq) const {
#pragma unroll
        for (int ai = 0; ai < 2; ++ai)
#pragma unroll
            for (int m = 0; m < 4; ++m) { const int r = ai * 128 + wr * 64 + m * 16 + fr;
                unsigned dst = *(const LAS unsigned*)(pre + ai * 256 + (m * 16 + fr) * 4); if (u.p0 + r >= u.cnt) dst = (unsigned)(HALFTOK * 9 + r);
                u32x4 wv;
#pragma unroll
                for (int bj = 0; bj < 2; ++bj)
#pragma unroll
                    for (int n = 0; n < 2; ++n) { const f32x4 v = acc[ai][bj][m][n] * (1.f / 32.f);
                        int p = __builtin_amdgcn_cvt_pk_fp8_f32(v[0], v[1], 0, false); p = __builtin_amdgcn_cvt_pk_fp8_f32(v[2], v[3], p, true); wv[2 * bj + n] = (unsigned)p; }
                __builtin_nontemporal_store(wv, (u32x4*)(y + (size_t)dst * DM + u.pn * 256 + wc * 64 + 16 * fq)); }
    }
};
DI int moe_build_table(const Frame& F0, int l, int half, int npn) {
    const Frame F = launder(F0);
    LAS int* tb = (LAS int*)(F.lds + LDSCTL_OFF + LC_TB); LAS int* cn = (LAS int*)(F.lds + LDSCTL_OFF + LC_CNT);
    LAS u32x4* utab = (LAS u32x4*)(F.lds + LDSCTL_OFF + LC_UTAB);
    __syncthreads();
    if (F.tid < NE1) cn[F.tid] = (F.tid < NE) ? (int)__hip_atomic_load(F.ctl + CW_CNT + ((l * 2 + half) * 64 + F.tid) * 16, __ATOMIC_RELAXED, __HIP_MEMORY_SCOPE_AGENT) : HALFTOK;
    __syncthreads();
    if (F.wave == 0) {
        const int lane = F.lane; const int c = cn[lane]; int t = (c + 255) >> 8;
#pragma unroll
        for (int o = 1; o < 64; o <<= 1) { const int t2 = __builtin_amdgcn_ds_bpermute((lane - o) << 2, t); if (lane >= o) t += t2; }
        tb[lane] = t - ((c + 255) >> 8);
        if (lane == 63) { tb[64] = t; tb[65] = t + ((HALFTOK + 255) >> 8); }
    }
    __syncthreads();
    const int total = tb[NE1] * npn;
    const int c = F.vcu;
    const int nmy = (total > c) ? (total - c + F.G - 1) / F.G : 0;
    for (int i = F.tid; i < nmy; i += 512) {
        const int L = i * F.G + c; const int tile = L / npn, pn = L % npn;
        int lo = 0, hi = NE1;
#pragma unroll 1
        while (hi - lo > 1) { const int mid = (lo + hi) >> 1; if (tb[mid] <= tile) lo = mid; else hi = mid; }
        utab[i] = (u32x4){(unsigned)tile, (unsigned)pn | ((unsigned)lo << 16), (unsigned)((tile - tb[lo]) * 256), (unsigned)cn[lo]};
    }
    __syncthreads();
    return nmy;
}

#define DPP_F(v, ctrl) __builtin_bit_cast(float, __builtin_amdgcn_update_dpp(0, __builtin_bit_cast(int, (v)), (ctrl), 0xf, 0xf, true))
#define DPP_I(v, ctrl) __builtin_amdgcn_update_dpp(0, (v), (ctrl), 0xf, 0xf, true)
DI float max8(float v) { v = fmaxf(v, DPP_F(v, 0xB1)); v = fmaxf(v, DPP_F(v, 0x4E)); v = fmaxf(v, DPP_F(v, 0x141)); return v; }
DI int min8(int v) { v = min(v, DPP_I(v, 0xB1)); v = min(v, DPP_I(v, 0x4E)); v = min(v, DPP_I(v, 0x141)); return v; }
DI float sum64(float v) {
    v += DPP_F(v, 0xB1); v += DPP_F(v, 0x4E); v += DPP_F(v, 0x141); v += DPP_F(v, 0x140);
    const float a = __builtin_bit_cast(float, __builtin_amdgcn_readlane(__builtin_bit_cast(int, v), 0)), b = __builtin_bit_cast(float, __builtin_amdgcn_readlane(__builtin_bit_cast(int, v), 16)),
                c = __builtin_bit_cast(float, __builtin_amdgcn_readlane(__builtin_bit_cast(int, v), 32)), d = __builtin_bit_cast(float, __builtin_amdgcn_readlane(__builtin_bit_cast(int, v), 48));
    return (a + b) + (c + d); }
DI void router_phase(const Frame& F0, int l, const bool dry = false) {
    const Frame F = launder(F0); KArgs& a = *F.ka; l = launder_s(l);
    const int lane = F.lane, w = F.wave, tid = F.tid, j31 = lane & 31, hf = lane >> 5;
    const bf16* X1 = (const bf16*)(F.ws + WS_XB);
    unsigned char* H8 = (unsigned char*)(F.ws + WS_H8);
    const float* mod = (const float*)(F.ws + WS_MOD) + (size_t)l * 8 * 6144;
    const bf16* WRT = (const bf16*)(F.ws + WS_WR) + (size_t)l * 131072 + (size_t)w * 8 * 2048;
    const unsigned wlo = (unsigned)lane * 8u;
    LAS float* redA = (LAS float*)(F.lds);
    LAS float* part = (LAS float*)(F.lds + 4096);
    LAS float* logitA = (LAS float*)(F.lds + 4096 + 65536);
    LAS int* lcnt = (LAS int*)(F.lds + 4096 + 65536 + 33280);
    LAS unsigned* selA = (LAS unsigned*)(F.lds + 4096 + 65536 + 33280 + 512);
    LAS float* selW = (LAS float*)(F.lds + 4096 + 65536 + 33280 + 512 + 4096);
    LAS float* gvec = (LAS float*)(F.lds + 4096 + 65536 + 33280 + 512 + 8192);
    LAS float* svec = gvec + 1024;
    u32x2* LIST = (u32x2*)(F.ws + WS_LIST);
    const float* rb = AIN(I_RB) + l * NE;
    const int pmode = dry ? 8 : a.probe;
    const int nun = (NTOK / 32 - F.vcu + F.G - 1) / F.G;
    f32x4 xv[8][2];
    auto load_x = [&](int unit) {
        const int tok = unit * 32 + j31;
#pragma unroll
        for (int st = 0; st < 8; ++st) { const u32x4 r = *(const u32x4*)(X1 + (size_t)tok * DM + 128 * w + 16 * st + 8 * hf);
            xv[st][0] = (f32x4){bflo(r.x), bfhi(r.x), bflo(r.y), bfhi(r.y)}; xv[st][1] = (f32x4){bflo(r.z), bfhi(r.z), bflo(r.w), bfhi(r.w)}; }
    };
    for (int u0 = 0; u0 < nun; u0 += 4) {
    const int ng = (nun - u0) < 4 ? (nun - u0) : 4;
    load_x(F.vcu + u0 * F.G);
    if (tid < 128) lcnt[tid] = 0;
    __syncthreads();
    for (int ug = 0; ug < ng; ++ug) {
        const int ui = u0 + ug, unit = F.vcu + ui * F.G;
        const int t0 = unit * 32, b = t0 >> 12;
        const int tok = t0 + j31;
        float ss = 0.f;
#pragma unroll
        for (int st = 0; st < 8; ++st)
#pragma unroll
            for (int q = 0; q < 2; ++q) ss += (xv[st][q].x * xv[st][q].x + xv[st][q].y * xv[st][q].y) + (xv[st][q].z * xv[st][q].z + xv[st][q].w * xv[st][q].w);
        ss += shx(ss, 32, lane);
        if (hf == 0) redA[w * 32 + j31] = ss;
        { const int c2 = 2 * tid; const f32x2 g = *(const f32x2*)(AIN(I_NFG) + l * DM + c2), sc = *(const f32x2*)(mod + b * 6144 + 4096 + c2), sh = *(const f32x2*)(mod + b * 6144 + 3072 + c2);
          *(LAS f32x2*)(gvec + c2) = g * (1.f + sc); *(LAS f32x2*)(svec + c2) = sh; }
        __syncthreads();
        float tot = 0.f;
#pragma unroll
        for (int q = 0; q < 8; ++q) tot += redA[q * 32 + j31];
        const float rinv = rsqrtf(tot * (1.f / DM) + EPS);
        f32x16 acc[2]; acc[0] = zero16(); acc[1] = zero16();
        if (pmode != 6 && pmode != 7) {
            bf16x8 Bh[8][2], Bl[8][2];
            auto ldB = [&](int st) {
#pragma unroll
                for (int eb = 0; eb < 2; ++eb) { const bf16* fp = (const bf16*)(const GAS bf16*)uniform_ptr(WRT + st * 2048 + eb * 1024); Bh[st][eb] = *(const bf16x8*)(fp + wlo); Bl[st][eb] = *(const bf16x8*)(fp + 512 + wlo); } };
            ldB(0); ldB(1);
#pragma unroll
            for (int st = 0; st < 8; ++st) { const int col = 128 * w + 16 * st + 8 * hf;
                if (st + 2 < 8) ldB(st + 2);
                asm volatile("" ::: "memory");
                float hv[8];
#pragma unroll
                for (int q = 0; q < 2; ++q) { const f32x4 g = *(const LAS f32x4*)(gvec + col + 4 * q), sh = *(const LAS f32x4*)(svec + col + 4 * q);
                    const f32x4 o = xv[st][q] * rinv * g + sh;
#pragma unroll
                    for (int e = 0; e < 4; ++e) hv[4 * q + e] = o[e]; }
                u32x4 hi4, lo4;
#pragma unroll
                for (int e = 0; e < 4; ++e) { hi4[e] = pk2(hv[2 * e], hv[2 * e + 1]); lo4[e] = pk2(hv[2 * e] - bflo(hi4[e]), hv[2 * e + 1] - bfhi(hi4[e])); }
                if (pmode != 14) { int q0 = __builtin_amdgcn_cvt_pk_fp8_f32(hv[0], hv[1], 0, false); q0 = __builtin_amdgcn_cvt_pk_fp8_f32(hv[2], hv[3], q0, true);
                    int q1 = __builtin_amdgcn_cvt_pk_fp8_f32(hv[4], hv[5], 0, false); q1 = __builtin_amdgcn_cvt_pk_fp8_f32(hv[6], hv[7], q1, true);
                    *(u32x2*)(H8 + (size_t)tok * DM + col) = (u32x2){(unsigned)q0, (unsigned)q1}; }
                const bf16x8 ahi = __builtin_bit_cast(bf16x8, hi4), alo = __builtin_bit_cast(bf16x8, lo4);
                if (pmode != 15)
#pragma unroll
                for (int eb = 0; eb < 2; ++eb) { acc[eb] = MFMA32(ahi, Bh[st][eb], acc[eb]); acc[eb] = MFMA32(alo, Bh[st][eb], acc[eb]); acc[eb] = MFMA32(ahi, Bl[st][eb], acc[eb]); }
            }
        }
        if (ug + 1 < ng) load_x(unit + F.G);
#pragma unroll
        for (int eb = 0; eb < 2; ++eb)
#pragma unroll
            for (int i = 0; i < 16; ++i) part[w * 2048 + (4 * hf + 8 * (i >> 2) + (i & 3)) * 64 + 32 * eb + j31] = acc[eb][i];
        __syncthreads();
#pragma unroll
        for (int q = 0; q < 4; ++q) { const int idx = tid + 512 * q; float s_ = 0.f;
#pragma unroll
            for (int ww = 0; ww < 8; ++ww) s_ += part[ww * 2048 + idx];
            logitA[(ug * 32 + (idx >> 6)) * 65 + (idx & 63)] = s_; }
    }
    __syncthreads();
    if (w < ng && lane < 32 && !(pmode == 5 || pmode == 7)) {
        int ln2 = lane; asm volatile("" : "+v"(ln2));
        const int ui = u0 + w, t = (F.vcu + ui * F.G) * 32 + ln2, half = t >> 14;
        const LAS float* lrow = logitA + (w * 32 + ln2) * 65;
        float m[64];
#pragma unroll
        for (int e = 0; e < 64; ++e) m[e] = __builtin_amdgcn_rcpf(1.f + __builtin_amdgcn_exp2f(-1.4426950408889634f * lrow[e])) + rb[e];
        float gs[8];
#pragma unroll
        for (int g = 0; g < 8; ++g) { float hi = -INFINITY, lo = -INFINITY;
#pragma unroll
            for (int i = 0; i < 8; ++i) { const float v = m[8 * g + i]; lo = fmaxf(lo, fminf(hi, v)); hi = fmaxf(hi, v); }
            gs[g] = hi + lo; }
#pragma unroll
        for (int g = 0; g < 8; ++g) { int r = 0;
#pragma unroll
            for (int g2 = 0; g2 < 8; ++g2) r += (gs[g2] > gs[g] || (gs[g2] == gs[g] && g2 < g)) ? 1 : 0;
            if (r >= 4) {
#pragma unroll
                for (int i = 0; i < 8; ++i) m[8 * g + i] = -INFINITY; } }
        int ei[8]; float sv[8]; float wsum = 0.f;
#pragma unroll
        for (int r = 0; r < 8; ++r) {
            float mx = m[0];
#pragma unroll
            for (int e = 1; e < 64; ++e) mx = fmaxf(mx, m[e]);
            int idx = 0;
#pragma unroll
            for (int e = 63; e >= 0; --e) idx = (m[e] == mx) ? e : idx;
#pragma unroll
            for (int e = 0; e < 64; ++e) m[e] = (e == idx) ? -INFINITY : m[e];
            const float val = __builtin_amdgcn_rcpf(1.f + __builtin_amdgcn_exp2f(-1.4426950408889634f * lrow[idx]));
            ei[r] = idx; sv[r] = val; wsum += val;
        }
        const float wn = 2.5f / wsum;
#pragma unroll
        for (int r = 0; r < 8; ++r) if (pmode != 8) {
            const int pl = __hip_atomic_fetch_add(lcnt + half * 64 + ei[r], 1, __ATOMIC_RELAXED, __HIP_MEMORY_SCOPE_WORKGROUP);
            const int slot = (w * 32 + ln2) * 8 + r;
            selA[slot] = (unsigned)ei[r] | ((unsigned)r << 8) | ((unsigned)pl << 16); selW[slot] = sv[r] * wn; }
    }
    __syncthreads();
    if (tid < 128 && pmode != 8) { const int c = lcnt[tid]; int gb = 0; if (c > 0) gb = (int)__hip_atomic_fetch_add(F.ctl + CW_CNT + ((l * 2 + (tid >> 6)) * 64 + (tid & 63)) * 16, (unsigned)c, __ATOMIC_RELAXED, __HIP_MEMORY_SCOPE_AGENT); lcnt[tid] = gb; }
    __syncthreads();
    for (int i = tid; i < ((pmode == 5 || pmode == 7 || pmode == 8) ? 0 : ng * 256); i += 512) {
        const int ug = i >> 8, tl = (i >> 3) & 31; const unsigned pa = selA[i]; const int e = pa & 0xff, rank = (pa >> 8) & 0xff, pl = pa >> 16;
        const int t = (F.vcu + (u0 + ug) * F.G) * 32 + tl, half = t >> 14, tk = t - half * HALFTOK;
        LIST[((size_t)half * NE1 + e) * LCAP + lcnt[half * 64 + e] + pl] = (u32x2){(unsigned)(tk * 9 + rank), __float_as_uint(selW[i])}; }
    for (int i = tid; i < (pmode == 8 ? 0 : ng * 32); i += 512) { const int t = (F.vcu + (u0 + (i >> 5)) * F.G) * 32 + (i & 31), half = t >> 14, tk = t - half * HALFTOK;
        LIST[((size_t)half * NE1 + NE) * LCAP + tk] = (u32x2){(unsigned)(tk * 9 + 8), __float_as_uint(1.0f)}; }
    __syncthreads();
    }
}

DI void combine_phase(const Frame& F0, int l, int half, bool probe = false) {
    const Frame F = launder(F0); KArgs& a = *F.ka; l = launder_s(l);
    const int gw = F.vcu * 8 + F.wave, NGW = F.G * 8, lane = F.lane;
    const float* mod = (const float*)(F.ws + WS_MOD) + (size_t)l * 8 * 6144;
    const float* modn = (const float*)(F.ws + WS_MOD) + (size_t)(l + 1) * 8 * 6144;
    const unsigned char* Y = (const unsigned char*)(F.ws + WS_Y);
    bf16* H = (bf16*)(F.ws + WS_H);
    const bf16* XB = (const bf16*)(F.ws + WS_XB); float* XF = ((float*)a.out);
    bf16* XO = probe ? (bf16*)(F.ws + WS_Y + 150 * MiB) : (bf16*)(F.ws + WS_XB); bf16* HO = probe ? (bf16*)(F.ws + WS_Y + 220 * MiB) : H;
    for (int ml = gw; ml < HALFTOK; ml += NGW) {
        const int m = half * HALFTOK + ml, b = m >> 12;
        f32x2 sacc[8];
#pragma unroll
        for (int q = 0; q < 8; ++q) sacc[q] = (f32x2){0.f, 0.f};
#pragma unroll
        for (int k = 0; k < 9; ++k) { const u32x4 raw = *(const u32x4*)(Y + ((size_t)ml * 9 + k) * DM + 16 * lane);
#pragma unroll
            for (int e = 0; e < 4; ++e) { sacc[2 * e] += __builtin_amdgcn_cvt_pk_f32_fp8((int)raw[e], false); sacc[2 * e + 1] += __builtin_amdgcn_cvt_pk_f32_fp8((int)raw[e], true); } }
        f32x4 xn[4]; float ss = 0.f;
        const u32x4 xr0 = *(const u32x4*)(XB + (size_t)m * DM + 16 * lane), xr1 = *(const u32x4*)(XB + (size_t)m * DM + 16 * lane + 8);
#pragma unroll
        for (int q = 0; q < 4; ++q) { const int c = 16 * lane + 4 * q;
            const unsigned wa = (q < 2 ? xr0 : xr1)[2 * (q & 1)], wb = (q < 2 ? xr0 : xr1)[2 * (q & 1) + 1];
            const f32x4 xv = (f32x4){bflo(wa), bfhi(wa), bflo(wb), bfhi(wb)}, g2 = *(const f32x4*)(mod + b * 6144 + 5120 + c);
            const f32x4 sv = (f32x4){sacc[2 * q].x, sacc[2 * q].y, sacc[2 * q + 1].x, sacc[2 * q + 1].y} * 0.125f;
            const f32x4 o = xv + g2 * sv; xn[q] = o;
            if (l == 1 && !probe) *(f32x4*)(XF + (size_t)m * DM + c) = o;
            ss += (o.x * o.x + o.y * o.y) + (o.z * o.z + o.w * o.w); }
        if (l == 0 || probe) { u32x4 w0, w1; w0.x = pk2(xn[0][0], xn[0][1]); w0.y = pk2(xn[0][2], xn[0][3]); w0.z = pk2(xn[1][0], xn[1][1]); w0.w = pk2(xn[1][2], xn[1][3]);
            w1.x = pk2(xn[2][0], xn[2][1]); w1.y = pk2(xn[2][2], xn[2][3]); w1.z = pk2(xn[3][0], xn[3][1]); w1.w = pk2(xn[3][2], xn[3][3]);
            *(u32x4*)(XO + (size_t)m * DM + 16 * lane) = w0; *(u32x4*)(XO + (size_t)m * DM + 16 * lane + 8) = w1; }
        if (l == 0 || probe) {
            const float rinv = rsqrtf(wave_sum(ss, F.lane) * (1.f / DM) + EPS);
            u32x4 wv[2];
#pragma unroll
            for (int q = 0; q < 4; ++q) { const int c = 16 * lane + 4 * q;
                const f32x4 g = *(const f32x4*)(AIN(I_NMG) + DM + c), sc = *(const f32x4*)(modn + b * 6144 + 1024 + c), sh = *(const f32x4*)(modn + b * 6144 + c);
                const f32x4 o = xn[q] * rinv * (g * (1.f + sc)) + sh;
                wv[q >> 1][2 * (q & 1)] = pk2(o[0], o[1]); wv[q >> 1][2 * (q & 1) + 1] = pk2(o[2], o[3]); }
            *(u32x4*)(HO + (size_t)m * DM + 16 * lane) = wv[0]; *(u32x4*)(HO + (size_t)m * DM + 16 * lane + 8) = wv[1];
        }
    }
}

DI void grid_sync(const Frame& F0) {
    const Frame F = launder(F0);
    XcdBarrier b; b.bar = F.ctl + CW_BAR; b.x = xb_xcc_id(); b.st = (volatile LAS unsigned*)(F.lds + LDSCTL_OFF + LC_BAR);
    xcd_barrier(b, F.wave);
}
constexpr int NPHASE = 2 + 2 * 11;
#ifndef PHASE_MASK
#define PHASE_MASK 0xFFFF
#endif
#define PM(i) ((PHASE_MASK >> (i)) & 1)
#define KA_NOW ((KArgs*)__builtin_amdgcn_kernarg_segment_ptr())
#define IN(k) (N_LAUNCH_MODE == 1 || (KA_NOW->ph_lo <= (k) && (k) < KA_NOW->ph_hi))
DI int rfl(int x) { return __builtin_amdgcn_readfirstlane(x); }
DI void ph_sync() { const Frame F = frame_now(); grid_sync(F); }
DI void ph_prologue() { const Frame F = frame_now(); p0_prologue(F); }
DI void ph_norm1() { const Frame F = frame_now(); norm1_phase(F, 0); }
DI void ph_inproj(int l) { const Frame F = frame_now(); l = launder_s(rfl(l));
    pg8::DenseSched S; S.init(NTOK, INP, F.G, (int)blockIdx.x);
    EpiIn E{(bf16*)(F.ws + WS_UV), (bf16*)(F.ws + WS_LAT)};
    pg8::gemm_phase<EpiIn, pg8::DenseSched>(F.lds, F.wave, (const bf16*)(F.ws + WS_H), (const bf16*)(F.ws + WS_WIN) + (size_t)l * INP * 1024, 1024, 1024, S, E);
    { const int rem = S.nwg % F.G; const int c = (int)blockIdx.x;
      if (rem > 0 && c >= rem) { __syncthreads(); conv_experts(F, 1, l * CONV_TAIL, (l + 1) * CONV_TAIL, c - rem, F.G - rem); } } }
DI void ph_mla(int l) { const Frame F = frame_now();
#pragma unroll 1
    for (int u = F.vcu; u < 256; u += F.G) mla_prep_unit(F, rfl(l), u); }
DI void ph_gmlp(int l) { const Frame F = frame_now();
#pragma unroll 1
    for (int u = F.vcu; u < 256; u += F.G) gmlp_unit(F, rfl(l), u); }
DI void ph_conv(int l) { const Frame F = frame_now();
    const int rem = ((NTOK / 256) * (INP / 256)) % F.G; conv_experts(F, rfl(l), rem > 0 ? 2 * CONV_TAIL : 0, CONV_ITEMS, F.vcu, F.G); }
DI void ph_attn(int l) { const Frame F = frame_now(); attn_phase(F, rfl(l)); }
DI void ph_outproj(int l) { const Frame F = frame_now(); l = launder_s(rfl(l));
    const float* modl = (const float*)(F.ws + WS_MOD) + (size_t)l * 8 * 6144;
    pg8::DenseSched S; S.init(NTOK, DM, F.G, (int)blockIdx.x);
    outproj_tables(F, S);
    bf16* XB = (bf16*)(F.ws + WS_XB);
    EpiOut E{l == 0 ? ((const float*)F.ka->in[I_X]) : (const float*)nullptr, XB, F.ka->probe ? (bf16*)(F.ws + WS_Y + 150 * MiB) : XB, modl + 2048, (const LAS float*)(F.lds + LDSCTL_OFF + LC_UTAB)};
    pg8::gemm_phase<EpiOut, pg8::DenseSched>(F.lds, F.wave, (const bf16*)(F.ws + WS_MIX), (const bf16*)(F.ws + WS_WOUT) + (size_t)l * 1024 * 1024, 1024, 1024, S, E); }
DI void ph_router(int l) { const Frame F = frame_now(); router_phase(F, rfl(l)); }
DI void ph_router_dry(int l) { const Frame F = frame_now(); router_phase(F, rfl(l), true); }
DI void ph_e1(int l, int half) { const Frame F = frame_now(); l = launder_s(rfl(l)); half = launder_s(rfl(half));
    const u32x2* list = (const u32x2*)(F.ws + WS_LIST) + (size_t)half * NE1 * LCAP;
    const int nmy = moe_build_table(F, l, half, 2);
    MoeSched<true> S{(const LAS u32x4*)(F.lds + LDSCTL_OFF + LC_UTAB), nmy, list, half};
    EpiE1 E{(unsigned char*)(F.ws + WS_ACT), list};
    pg8::gemm_phase<EpiE1, MoeSched<true>, true>(F.lds, F.wave, (const bf16*)(F.ws + WS_H8), (const bf16*)(F.ws + WS_WGU + (size_t)l * WGU_L), 512, 512, S, E); }
DI void ph_e2(int l, int half) { const Frame F = frame_now(); l = launder_s(rfl(l)); half = launder_s(rfl(half));
    const u32x2* list = (const u32x2*)(F.ws + WS_LIST) + (size_t)half * NE1 * LCAP;
    const int nmy = moe_build_table(F, l, half, 4);
    MoeSched<false> S{(const LAS u32x4*)(F.lds + LDSCTL_OFF + LC_UTAB), nmy, list, half};
    EpiE2 E{(unsigned char*)(F.ws + WS_Y), list};
    pg8::gemm_phase<EpiE2, MoeSched<false>, true>(F.lds, F.wave, (const bf16*)(F.ws + WS_ACT), (const bf16*)(F.ws + WS_WD + (size_t)l * WD_L), 128, 128, S, E); }
DI void ph_combine(int l, int half) { const Frame F = frame_now(); combine_phase(F, rfl(l), rfl(half), F.ka->probe != 0); }

__global__ void __launch_bounds__(512, 2) trunk_fwd(Args args) {
    Frame F;
    {
        LAS unsigned char* lds0 = (LAS unsigned char*)lds_raw;
        for (int u = (int)threadIdx.x; u < (LDS_BYTES - LDSCTL_OFF) / 4; u += 512) ((LAS unsigned*)(lds0 + LDSCTL_OFF))[u] = 0u;
        __syncthreads();
        if ((threadIdx.x & 63) == 0) *(volatile LAS unsigned char*)(lds0 + LDSCTL_OFF + LC_WTAB + hw_wave_key()) = (unsigned char)(threadIdx.x >> 6);
        __syncthreads();
        F = frame_now();
        if (N_LAUNCH_MODE == 1) (void)xcd_barrier_post(F.ctl + CW_BAR, (volatile LAS unsigned*)(F.lds + LDSCTL_OFF + LC_BAR));
    }
#define SEAMK() do { if (N_LAUNCH_MODE == 1) ph_sync(); } while (0)
    if (PM(0) && IN(0)) ph_prologue();
    SEAMK();
    if (PM(1) && IN(1)) ph_norm1();
    SEAMK();
#pragma unroll 1
    for (int l = 0; l < 2; ++l) {
        const int pb = 2 + 11 * l;
        if (PM(2) && IN(pb + 0)) ph_inproj(l);
        SEAMK();
        if (PM(3) && IN(pb + 1)) {
            if (KA_NOW->probe == 0 || KA_NOW->probe == 2 || (KA_NOW->probe >= 11 && KA_NOW->probe <= 13)) ph_mla(l);
            if (KA_NOW->probe == 0 || KA_NOW->probe == 3) ph_gmlp(l);
            if (l == 1 && (KA_NOW->probe == 0 || KA_NOW->probe == 4)) ph_conv(1);
        }
        SEAMK();
        if (PM(4) && IN(pb + 2)) ph_attn(l);
        SEAMK();
        if (PM(5) && IN(pb + 3)) ph_outproj(l);
        SEAMK();
        if (PM(6) && IN(pb + 4)) ph_router(l);
        SEAMK();
#if defined(ROUTER_DRY_REPS)
#pragma unroll 1
        for (int r = 0; r < ROUTER_DRY_REPS; ++r) { ph_router_dry(l); SEAMK(); }
#endif
#pragma unroll 1
        for (int half = 0; half < 2; ++half) {
            const int ph = pb + 5 + 3 * half;
            if (PM(7) && IN(ph)) ph_e1(l, half);
            SEAMK();
            if (PM(8) && IN(ph + 1)) ph_e2(l, half);
            SEAMK();
            if (PM(9) && IN(ph + 2)) ph_combine(l, half);
            if (!(l == 1 && half == 1)) SEAMK();
        }
    }
#if defined(EXTRA_SYNCS)
#pragma unroll 1
    for (int r = 0; r < EXTRA_SYNCS; ++r) SEAMK();
#endif
#undef IN
}

extern "C" void kernel_launch(void* const* d_in, const int* in_sizes, int n_in, void* d_out, int out_size, void* d_ws, size_t ws_size, hipStream_t stream) {
    static int grid = 0;
    if (grid == 0) {
        if (n_in != 28 || out_size != NTOK * DM || ws_size < WS_END) { fprintf(stderr, "kernel_launch: unexpected problem (n_in %d out %d ws %zu need %zu)\n", n_in, out_size, ws_size, (size_t)WS_END); grid = -1; return; }
        int dev = 0, cus = 0;
        if (hipGetDevice(&dev) != hipSuccess || hipDeviceGetAttribute(&cus, hipDeviceAttributeMultiprocessorCount, dev) != hipSuccess) { grid = -1; return; }
        if (hipFuncSetAttribute((const void*)trunk_fwd, hipFuncAttributeMaxDynamicSharedMemorySize, LDS_BYTES) != hipSuccess) { fprintf(stderr, "kernel_launch: hipFuncSetAttribute failed\n"); grid = -1; return; }
        int per_cu = 0;
        (void)hipOccupancyMaxActiveBlocksPerMultiprocessor(&per_cu, (const void*)trunk_fwd, 512, LDS_BYTES);
        (void)hipGetLastError();
        grid = cus;
    }
    if (grid < 0) return;
    (void)hipMemsetAsync((char*)d_ws + WS_CTL, 0, CTL_BYTES, stream);
    Args a{};
    for (int i = 0; i < 28; ++i) a.in[i] = (const GAS float*)d_in[i];
    a.out = (GAS float*)d_out; a.ws = (GAS unsigned char*)d_ws; a.G = grid;
    if (N_LAUNCH_MODE == 1) {
        a.ph_lo = 0; a.ph_hi = NPHASE;
        hipLaunchKernelGGL(trunk_fwd, dim3(grid), dim3(512), LDS_BYTES, stream, a);
    } else {
        for (int p = 0; p < NPHASE; ++p) { a.ph_lo = p; a.ph_hi = p + 1; hipLaunchKernelGGL(trunk_fwd, dim3(grid), dim3(512), LDS_BYTES, stream, a); }
#if defined(PROBE_PHASE)
        for (int r = 0; r < PROBE_REPS; ++r) { a.ph_lo = PROBE_PHASE; a.ph_hi = PROBE_PHASE + 1; a.probe = PROBE_SUB; hipLaunchKernelGGL(trunk_fwd, dim3(grid), dim3(512), LDS_BYTES, stream, a); }
#endif
    }
}
```

```cpp
#include <hip/hip_runtime.h>
#include <cstdio>
#include <cstdint>

#define DI __device__ __forceinline__
#define LAS __attribute__((address_space(3)))
typedef unsigned short bf16;
typedef short bf16x8 __attribute__((ext_vector_type(8)));
typedef float f32x2 __attribute__((ext_vector_type(2)));
typedef float f32x4 __attribute__((ext_vector_type(4)));
typedef float f32x16 __attribute__((ext_vector_type(16)));
typedef unsigned u32x2 __attribute__((ext_vector_type(2)));
typedef unsigned u32x4 __attribute__((ext_vector_type(4)));
typedef __bf16 bf16x2v __attribute__((ext_vector_type(2)));

#ifndef OUT_MID
#define OUT_MID 1
#endif
#ifndef N_LAUNCH_MODE
#define N_LAUNCH_MODE 1
#endif

constexpr int NTOK = 32768, DM = 1024, SEQ = 4096, NB = 8, NH = 8, QKD = 96, VD = 64;
constexpr int INC = 1696, INP = 1792, LATW = 768, QL = 384, KVL = 256;
constexpr int NE = 64, NE1 = 65, FF = 256, HALFTOK = 16384, LCAP = 16384;
constexpr float EPS = 1e-6f;
constexpr float QSCALE = 0.10206207261596575f * 1.4426950408889634f;

constexpr size_t MiB = 1u << 20;
constexpr size_t WS_CTL = 0, CTL_BYTES = 256 * 1024;
constexpr size_t WS_MOD = 1 * MiB;
constexpr size_t WS_SMB = 1 * MiB + 512 * 1024;
constexpr size_t WS_COS = 2 * MiB, WS_SIN = 4 * MiB;
constexpr size_t WS_WIN = 6 * MiB;
constexpr size_t WS_WQ = 13 * MiB;
constexpr size_t WS_WKV = 15 * MiB;
constexpr size_t WS_WOUT = 16 * MiB;
constexpr size_t WS_WR = 20 * MiB;
constexpr size_t WS_WS = 20 * MiB + 512 * 1024;
constexpr size_t WS_RGM = 21 * MiB;
constexpr size_t WS_SSQ = 21 * MiB + 256 * 1024;
constexpr size_t WS_WGU = 23 * MiB;
constexpr size_t WS_WD = 88 * MiB;
constexpr size_t WGU_L = (size_t)65 * 512 * 1024, WD_L = (size_t)65 * 1024 * 256;
constexpr int CONV_ITEMS = 65 * 384, CONV_TAIL = 6144, CONV_E1LO = 2 * CONV_TAIL, CONV_E1HI = 65 * 256;
constexpr size_t WS_H = 121 * MiB;
constexpr size_t WS_OV = 185 * MiB;
constexpr size_t WS_UV = WS_OV;
constexpr size_t WS_LAT = WS_OV + 64 * MiB;
constexpr size_t WS_Q = WS_OV + 112 * MiB;
constexpr size_t WS_K = WS_OV + 160 * MiB;
constexpr size_t WS_VT = WS_OV + 208 * MiB;
constexpr size_t WS_MIX = WS_OV + 240 * MiB;
constexpr size_t WS_LIST = WS_OV;
constexpr size_t WS_ACT = WS_OV + 17 * MiB;
constexpr size_t WS_Y = WS_OV + 98 * MiB;
__host__ __device__ __forceinline__ int moe_ptok(int) { return 32768; }
__host__ __device__ __forceinline__ int moe_shift(int) { return 15; }
__host__ __device__ __forceinline__ size_t moe_list_off(int l) { return 88 * MiB + (l == 0 ? (size_t)65 * 1024 * 256 : 0); }
__host__ __device__ __forceinline__ size_t moe_act_off(int) { return 121 * MiB; }
__host__ __device__ __forceinline__ size_t moe_y_off(int) { return 197 * MiB; }
constexpr size_t WS_XB = WS_OV + 304 * MiB;
constexpr size_t WS_H8 = WS_OV + 368 * MiB;
constexpr size_t WS_END = WS_OV + 400 * MiB;
constexpr int CW_BAR = 1024;
constexpr int CW_CNT = 8192;

constexpr int RING_BYTES = 131072;
constexpr int LDSCTL_OFF = RING_BYTES;
constexpr int LC_BAR = 0;
constexpr int LC_TB = 64;
constexpr int LC_CNT = 64 + 66 * 4;
constexpr int LC_WTAB = 768;
constexpr int LC_UTAB = 1024;
constexpr int LC_PRE = 2048;
constexpr int LC_NXT = 6144;
constexpr int LDS_BYTES = 147456;

DI unsigned pk2(float lo, float hi) { f32x2 v = {lo, hi}; bf16x2v r = __builtin_convertvector(v, bf16x2v); return __builtin_bit_cast(unsigned, r); }
DI float bflo(unsigned w) { return __uint_as_float(w << 16); }
DI float bfhi(unsigned w) { return __uint_as_float(w & 0xffff0000u); }
DI float bf2f(unsigned short h) { return __uint_as_float((unsigned)h << 16); }
DI unsigned short f2bf(float f) { return (unsigned short)(pk2(f, 0.f) & 0xffffu); }
DI float shx(float v, int m, int lane) { return __builtin_bit_cast(float, __builtin_amdgcn_ds_bpermute((lane ^ m) << 2, __builtin_bit_cast(int, v))); }
DI int shxi(int v, int m, int lane) { return __builtin_amdgcn_ds_bpermute((lane ^ m) << 2, v); }
DI float shf(float v, int src) { return __builtin_bit_cast(float, __builtin_amdgcn_ds_bpermute(src << 2, __builtin_bit_cast(int, v))); }
DI float wave_sum(float v, int lane) {
#pragma unroll
    for (int o = 1; o < 64; o <<= 1) v += shx(v, o, lane);
    return v;
}
DI const void* uniform_ptr(const void* p) { const unsigned long long v = (unsigned long long)p; const unsigned lo = (unsigned)__builtin_amdgcn_readfirstlane((int)(unsigned)v), hi = (unsigned)__builtin_amdgcn_readfirstlane((int)(unsigned)(v >> 32)); return (const void*)(((unsigned long long)hi << 32) | lo); }
DI int lane_id() { int l; asm volatile("v_mbcnt_lo_u32_b32 %0, -1, 0\n\tv_mbcnt_hi_u32_b32 %0, -1, %0" : "=v"(l)); return l; }
#define MFMA32(a, b, c) __builtin_amdgcn_mfma_f32_32x32x16_bf16((a), (b), (c), 0, 0, 0)
DI f32x16 zero16() { f32x16 z;
#pragma unroll
    for (int i = 0; i < 16; ++i) z[i] = 0.f; return z; }

namespace pg8 {
constexpr int BM = 256, BK = 64, HALF = 128, HTB = HALF * BK * 2, STAGE_BYTES = 8 * HTB, NXCD = 8, WGM = 8;
__host__ __device__ __forceinline__ int lds_byte(int r, int c) { const int st = (r >> 4) * 2 + (c >> 5), rr = r & 15, cc = c & 31, ob = rr * 64 + cc * 2; return st * 1024 + (ob ^ (((ob >> 9) & 1) << 5)); }
__host__ __device__ __forceinline__ void stage_rc(int b, int& R, int& C) { const int st = b / 1024, sb = b % 1024, swz = sb ^ (((sb >> 9) & 1) << 5); R = (st >> 1) * 16 + swz / 64; C = (st & 1) * 32 + (swz % 64) / 2; }
__host__ __device__ __forceinline__ int perm32(int rho) { const int n = rho >> 4, i = rho & 15; return 8 * (i >> 2) + 4 * n + (i & 3); }

struct Unit { int pm, pn, e, p0, cnt; };

DI f32x2 gelu_pk(f32x2 v) {
    const f32x2 av = __builtin_elementwise_abs(v), d = av * 0.2316418882f + 1.0f;
    f32x2 t; t.x = __builtin_amdgcn_rcpf(d.x); t.y = __builtin_amdgcn_rcpf(d.y);
    f32x2 q = t * 0.5307027145f + (-0.7265760135f); q = q * t + 0.7107068705f; q = q * t + (-0.142248368f); q = q * t + 0.127414796f; q = q * t;
    const f32x2 s = (v * v) * (-0.72134752044f);
    f32x2 e; e.x = __builtin_amdgcn_exp2f(s.x); e.y = __builtin_amdgcn_exp2f(s.y);
    const f32x2 m = v * (q * e), r = v - m;
    f32x2 o; o.x = v.x < 0.f ? m.x : r.x; o.y = v.y < 0.f ? m.y : r.y; return o;
}

typedef int i32x8 __attribute__((ext_vector_type(8)));
template <class Epi, class Sched, bool FP8 = false, bool ONEIT = false, bool PEEL0 = false>
DI void gemm_phase(LAS unsigned char* lds_in, const int wave_in, const bf16* Abase, const bf16* Btbase, const int K_in, const int lda, const Sched& S, const Epi& E) {
    int K = K_in; asm volatile("" : "+s"(K));
    LAS unsigned char* lds; { unsigned lb = (unsigned)(size_t)lds_in; asm volatile("" : "+s"(lb)); lds = (LAS unsigned char*)lb; }
    const int lane_ = lane_id();
    const int wid = wave_in, lane = lane_, tid = wid * 64 + lane, wr = wid >> 2, wc = wid & 3, fr = lane & 15, fq = lane >> 4;
    const int nt = K / BK;
    unsigned voffB[2];
#pragma unroll
    for (int i = 0; i < 2; ++i) { int R_, C_; stage_rc(tid * 16 + i * 8192, R_, C_); const int Rb = Epi::bsrc(R_);
        voffB[i] = (unsigned)(Rb * K + C_) * 2u; }
    LAS u32x4* park = (LAS u32x4*)(lds + 131072 + 8192) + tid;
    LAS unsigned char* const prel = lds + 131072 + LC_PRE + wid * 512;
    LAS unsigned char* const nxl = lds + 131072 + LC_NXT + (wid >> 2) * 1024;
    constexpr bool EXACT = Epi::NST >= 0;
    constexpr int XN = EXACT ? Epi::NST + Epi::NPRE + Sched::NDMA : 0;
    static_assert(XN + 8 <= 63, "vmcnt range");
    const size_t kstep = (size_t)(BK * 2);
    const size_t hstep = (size_t)Epi::HROWS * K * 2;
    unsigned ldsw = (unsigned)wid * 1024u;
    const int aoff = lds_byte(wr * 64 + fr, fq * 8), boff = lds_byte(wc * 32 + fr, fq * 8);
    constexpr int KSTR = 1024;
    const char* Ab = (const char*)Abase;
#define PG8_SA(b, h) (((b) * 2 + (h)) * HTB)
#define PG8_SB(b, h) ((4 + (b) * 2 + (h)) * HTB)
#define PG8_STAGE(bufoff, gbase, voff) do { _Pragma("unroll") for (int _i = 0; _i < 2; ++_i) \
        __builtin_amdgcn_global_load_lds((const unsigned*)((const char*)(gbase) + (voff)[_i]), (LAS unsigned*)(lds + (bufoff) + ldsw + _i * 8192), 16, 0, 0); } while (0)
#define PG8_LDA(dst, b, h) do { _Pragma("unroll") for (int m = 0; m < 4; ++m) _Pragma("unroll") for (int k = 0; k < 2; ++k) dst[m][k] = *(const LAS bf16x8*)(lds + PG8_SA(b, h) + aoff + m * 2048 + k * KSTR); } while (0)
#define PG8_LDB(dst, b, h) do { _Pragma("unroll") for (int n = 0; n < 2; ++n) _Pragma("unroll") for (int k = 0; k < 2; ++k) dst[n][k] = *(const LAS bf16x8*)(lds + PG8_SB(b, h) + boff + n * 2048 + k * KSTR); } while (0)
#define PG8_MMA(ai, bj, At, Bt) do { __builtin_amdgcn_s_setprio(1); _Pragma("unroll") for (int m = 0; m < 4; ++m) _Pragma("unroll") for (int n = 0; n < 2; ++n) { \
        if constexpr (FP8) { const i32x8 a8 = __builtin_bit_cast(i32x8, __builtin_shufflevector(At[m][0], At[m][1], 0, 1, 2, 3, 4, 5, 6, 7, 8, 9, 10, 11, 12, 13, 14, 15)), b8 = __builtin_bit_cast(i32x8, __builtin_shufflevector(Bt[n][0], Bt[n][1], 0, 1, 2, 3, 4, 5, 6, 7, 8, 9, 10, 11, 12, 13, 14, 15)); \
            acc[ai][bj][m][n] = __builtin_amdgcn_mfma_scale_f32_16x16x128_f8f6f4(b8, a8, acc[ai][bj][m][n], 0, 0, 0, 0x7f7f7f7f, 0, 0x7f7f7f7f); } \
        else { _Pragma("unroll") for (int k = 0; k < 2; ++k) acc[ai][bj][m][n] = __builtin_amdgcn_mfma_f32_16x16x32_bf16(Bt[n][k], At[m][k], acc[ai][bj][m][n], 0, 0, 0); } } \
        __builtin_amdgcn_s_setprio(0); } while (0)
#define PG8_MMAZ(ai, bj, At, Bt) do { __builtin_amdgcn_s_setprio(1); _Pragma("unroll") for (int m = 0; m < 4; ++m) _Pragma("unroll") for (int n = 0; n < 2; ++n) { \
        if constexpr (FP8) { const i32x8 a8 = __builtin_bit_cast(i32x8, __builtin_shufflevector(At[m][0], At[m][1], 0, 1, 2, 3, 4, 5, 6, 7, 8, 9, 10, 11, 12, 13, 14, 15)), b8 = __builtin_bit_cast(i32x8, __builtin_shufflevector(Bt[n][0], Bt[n][1], 0, 1, 2, 3, 4, 5, 6, 7, 8, 9, 10, 11, 12, 13, 14, 15)); \
            acc[ai][bj][m][n] = __builtin_amdgcn_mfma_scale_f32_16x16x128_f8f6f4(b8, a8, (f32x4){0.f, 0.f, 0.f, 0.f}, 0, 0, 0, 0x7f7f7f7f, 0, 0x7f7f7f7f); } \
        else { acc[ai][bj][m][n] = __builtin_amdgcn_mfma_f32_16x16x32_bf16(Bt[n][0], At[m][0], (f32x4){0.f, 0.f, 0.f, 0.f}, 0, 0, 0); acc[ai][bj][m][n] = __builtin_amdgcn_mfma_f32_16x16x32_bf16(Bt[n][1], At[m][1], acc[ai][bj][m][n], 0, 0, 0); } } \
        __builtin_amdgcn_s_setprio(0); } while (0)
#define PG8_WAIT_V(n) asm volatile("s_waitcnt vmcnt(" #n ")" ::: "memory")
#define PG8_WAIT_F() do { if constexpr (EXACT) asm volatile("s_waitcnt vmcnt(%1)\n\ts_cmp_lg_u32 %0, 0\n\ts_cbranch_scc1 1f\n\ts_waitcnt vmcnt(8)\n1:" :: "s"(fflag), "i"(8 + XN) : "scc", "memory"); \
        else asm volatile("s_waitcnt vmcnt(8)" ::: "memory"); } while (0)
#define PG8_WAIT_L(n) asm volatile("s_waitcnt lgkmcnt(" #n ")" ::: "memory")
#define PG8_BAR __builtin_amdgcn_s_barrier()
#define PG8_SCHED __builtin_amdgcn_sched_barrier(0)
    Unit cur; int ui = 0;
    if (!S.next(0, cur)) return;
    f32x4 acc[2][2][4][2];
#pragma unroll
    for (int a = 0; a < 2; ++a)
#pragma unroll
        for (int b = 0; b < 2; ++b)
#pragma unroll
            for (int m = 0; m < 4; ++m)
#pragma unroll
                for (int n = 0; n < 2; ++n) acc[a][b][m][n] = (f32x4){0.f, 0.f, 0.f, 0.f};
    bf16x8 At[4][2], B0[2][2], B1[2][2];
    unsigned oc[2][2];
    S.a_offs(cur, tid, lda, oc);
    E.prefetch(cur, prel, wr, lane);
    const char* cB = (const char*)Btbase + S.b_off(cur, K);
    PG8_STAGE(PG8_SB(0, 0), cB, voffB); PG8_STAGE(PG8_SB(0, 1), cB + hstep, voffB); PG8_STAGE(PG8_SA(0, 0), Ab, oc[0]); PG8_STAGE(PG8_SA(0, 1), Ab, oc[1]);
    if (wr == 1) PG8_BAR;
    PG8_WAIT_V(2); PG8_BAR;
    PG8_STAGE(PG8_SB(1, 0), cB + kstep, voffB); PG8_STAGE(PG8_SA(1, 0), Ab + kstep, oc[0]); PG8_STAGE(PG8_SB(1, 1), cB + hstep + kstep, voffB); PG8_STAGE(PG8_SA(1, 1), Ab + kstep, oc[1]);
    PG8_WAIT_V(8); PG8_BAR;
    for (;;) {
        bool has_next; const char* nB = cB;
        { unsigned on[2][2]; Unit nxt;
          has_next = S.next(ui + 1, nxt);
          if constexpr (Sched::NDMA != 0) { if (has_next) nB = (const char*)Btbase + S.b_off(nxt, K); else nxt = cur; S.dma_next(nxt, nxl, wid, lane); }
          else {
          if (has_next) { S.a_offs(nxt, tid, lda, on); nB = (const char*)Btbase + S.b_off(nxt, K); }
          else {
#pragma unroll
            for (int h = 0; h < 2; ++h)
#pragma unroll
                for (int i = 0; i < 2; ++i) on[h][i] = oc[h][i];
          }
          *park = (u32x4){on[0][0], on[0][1], on[1][0], on[1][1]}; } }
        int fflag = __builtin_amdgcn_readfirstlane((EXACT && ui > 0) ? 1 : 0); asm volatile("" : "+s"(fflag));
        for (int t = 0; t < (ONEIT ? 2 : nt); t += 2) {
            const bool last = ONEIT ? true : (t == nt - 2);
            asm volatile("" : "+s"(ldsw));
            if constexpr (Epi::MID) { if (t == (nt >> 1)) E.mid(acc, cur, wr, fr); }
            const char* a2 = last ? Ab : Ab + (size_t)(t + 2) * kstep; const char* b2 = last ? nB : cB + (size_t)(t + 2) * kstep;
            const char* a3 = a2 + kstep; const char* b3 = b2 + kstep;
            PG8_LDB(B0, 0, 0); PG8_LDB(B1, 0, 1); PG8_SCHED; PG8_LDA(At, 0, 0);
            if (last) { if constexpr (Sched::NDMA != 0) S.offs_lds(nxl, tid, lda, oc); else { const u32x4 pv = *park; oc[0][0] = pv.x; oc[0][1] = pv.y; oc[1][0] = pv.z; oc[1][1] = pv.w; } }
            PG8_WAIT_F(); PG8_WAIT_L(0); PG8_BAR; if (ONEIT || (PEEL0 && t == 0)) { PG8_MMAZ(0, 0, At, B0); PG8_MMAZ(0, 1, At, B1); } else { PG8_MMA(0, 0, At, B0); PG8_MMA(0, 1, At, B1); } PG8_BAR; PG8_SCHED;
            PG8_LDA(At, 0, 1); PG8_STAGE(PG8_SB(0, 0), b2, voffB); PG8_STAGE(PG8_SB(0, 1), b2 + hstep, voffB); PG8_STAGE(PG8_SA(0, 0), a2, oc[0]);
            PG8_WAIT_F(); PG8_WAIT_L(0); PG8_BAR; if (ONEIT || (PEEL0 && t == 0)) { PG8_MMAZ(1, 0, At, B0); PG8_MMAZ(1, 1, At, B1); } else { PG8_MMA(1, 0, At, B0); PG8_MMA(1, 1, At, B1); } PG8_BAR; PG8_SCHED;
            PG8_LDB(B0, 1, 0); PG8_LDB(B1, 1, 1); PG8_SCHED; PG8_LDA(At, 1, 0); PG8_STAGE(PG8_SA(0, 1), a2, oc[1]);
            PG8_WAIT_F(); PG8_WAIT_L(0); PG8_BAR; PG8_MMA(0, 0, At, B0); PG8_MMA(0, 1, At, B1); PG8_BAR; PG8_SCHED;
            PG8_LDA(At, 1, 1); PG8_STAGE(PG8_SB(1, 0), b3, voffB); PG8_STAGE(PG8_SB(1, 1), b3 + hstep, voffB); PG8_STAGE(PG8_SA(1, 0), a3, oc[0]);
            PG8_WAIT_V(8); PG8_WAIT_L(0); PG8_BAR; PG8_MMA(1, 0, At, B0); PG8_MMA(1, 1, At, B1); PG8_BAR; PG8_SCHED;
            PG8_STAGE(PG8_SA(1, 1), a3, oc[1]);
            if constexpr (EXACT) { fflag = __builtin_amdgcn_readfirstlane(0); asm volatile("" : "+s"(fflag)); }
        }
        asm volatile("" ::: "memory"); PG8_SCHED;
        if (wr == 0) PG8_BAR;
        E(acc, prel, cur, wr, wc, fr, fq);
        asm volatile("" ::: "memory"); PG8_SCHED;
        if (!has_next) break;
        if constexpr (!ONEIT && !PEEL0) {
#pragma unroll
        for (int a = 0; a < 2; ++a)
#pragma unroll
            for (int b = 0; b < 2; ++b)
#pragma unroll
                for (int m = 0; m < 4; ++m)
#pragma unroll
                    for (int n = 0; n < 2; ++n) acc[a][b][m][n] = (f32x4){0.f, 0.f, 0.f, 0.f}; }
        ++ui; (void)S.next(ui, cur); cB = (const char*)Btbase + S.b_off(cur, K);
        E.prefetch(cur, prel, wr, lane);
        if (wr == 1) PG8_BAR;
    }
    PG8_WAIT_V(0);
    PG8_BAR;
#undef PG8_SA
#undef PG8_SB
#undef PG8_STAGE
#undef PG8_LDA
#undef PG8_LDB
#undef PG8_MMA
#undef PG8_MMAZ
#undef PG8_WAIT_V
#undef PG8_WAIT_F
#undef PG8_WAIT_L
#undef PG8_BAR
#undef PG8_SCHED
}

struct DenseSched {
    static constexpr int NDMA = 0;
    DI void dma_next(const Unit&, LAS unsigned char*, int, int) const {}
    DI void offs_lds(LAS unsigned char*, int, int, unsigned (&)[2][2]) const {}
    int nM, nN, nwg, G, c;
    DI void init(int M, int N, int G_, int c_) { nM = M / BM; nN = N / BM; nwg = nM * nN; G = G_; c = c_; }
    DI bool next(int i, Unit& u) const {
        const long L = (long)i * G + c; if (L >= nwg) return false;
        int wgid = (int)L; { const int q = nwg / NXCD, r = nwg % NXCD, xcd = wgid % NXCD, off = wgid / NXCD; wgid = (xcd < r ? xcd * (q + 1) : r * (q + 1) + (xcd - r) * q) + off; }
        const int nig = WGM * nN, gid = wgid / nig, fm = gid * WGM, gsz = (nM - fm) < WGM ? (nM - fm) : WGM;
        u.pm = fm + ((wgid % nig) % gsz); u.pn = (wgid % nig) / gsz; u.e = i; u.p0 = 0; u.cnt = 0; return true;
    }
    DI void a_offs(const Unit& u, int tid, int lda, unsigned (&o)[2][2]) const {
#pragma unroll
        for (int i = 0; i < 2; ++i) { int R, C; stage_rc(tid * 16 + i * 8192, R, C);
#pragma unroll
            for (int h = 0; h < 2; ++h) o[h][i] = (unsigned)((u.pm * BM + h * HALF + R) * lda + C) * 2u; }
    }
    DI size_t b_off(const Unit& u, int K) const { return (size_t)u.pn * BM * K * 2; }
};
}

#define XB_TMO      128
#define XB_XCNT(j)  (256  + 64 * (j))
#define XB_XSUB(j)  (1280 + 64 * (j))
#define XB_XGEN(j)  (2304 + 64 * (j))
#define XB_TOP      3328
#define XB_TOPGEN   3392
#define XCD_BAR_WORDS 3456
#define XB_SPIN_CAP (1u << 18)
DI unsigned xb_ld(unsigned* p)              { return __hip_atomic_load(p, __ATOMIC_RELAXED, __HIP_MEMORY_SCOPE_AGENT); }
DI unsigned xb_add(unsigned* p, unsigned v) { return __hip_atomic_fetch_add(p, v, __ATOMIC_RELAXED, __HIP_MEMORY_SCOPE_AGENT); }
DI unsigned xb_xcc_id() { return (unsigned)__builtin_amdgcn_s_getreg((3 << 11) | 20) & 0xFu; }
#define XB_SPIN(cond, bar) do { unsigned _sp = 0; while (cond) { __builtin_amdgcn_s_sleep(1); \
    if ((++_sp & 255u) == 0u) { if (xb_ld(&(bar)[XB_TMO])) break; if (_sp > XB_SPIN_CAP) { atomicAdd(&(bar)[XB_TMO], 1u); break; } } } } while (0)
struct XcdBarrier { unsigned* bar; unsigned x; volatile LAS unsigned* st; };
DI XcdBarrier xcd_barrier_post(unsigned* bar, volatile LAS unsigned* st) {
    XcdBarrier b; b.bar = bar; b.x = xb_xcc_id(); b.st = st;
    if (threadIdx.x == 0) (void)xb_add(&bar[XB_XCNT(b.x)], 1u);
    return b;
}
DI void xcd_barrier_complete(unsigned* bar, unsigned x, unsigned& nloc, unsigned& nx) {
    const unsigned G = gridDim.x * gridDim.y * gridDim.z;
    unsigned sum, cnt, mine, sp = 0u;
    for (;;) {
        sum = 0u; cnt = 0u; mine = 0u;
#pragma unroll
        for (unsigned j = 0; j < 16; ++j) { const unsigned c = xb_ld(&bar[XB_XCNT(j)]); sum += c; cnt += (c > 0u) ? 1u : 0u; mine = (j == x) ? c : mine; }
        if (sum == G) break;
        __builtin_amdgcn_s_sleep(1);
        if ((++sp & 255u) == 0u) { if (xb_ld(&bar[XB_TMO])) break; if (sp > XB_SPIN_CAP) { atomicAdd(&bar[XB_TMO], 1u); break; } }
    }
    nloc = mine > 0u ? mine : 1u; nx = cnt > 0u ? cnt : 1u;
}
DI void xcd_barrier(const XcdBarrier& b, int wave) {
    asm volatile("s_waitcnt vmcnt(0)" ::: "memory");
    __syncthreads();
    if (wave == 0 && lane_id() == 0) {
        unsigned* bar = b.bar;
        __builtin_amdgcn_s_waitcnt(0);
        unsigned nloc = b.st[0], nx = b.st[1];
        if (nloc == 0u) { xcd_barrier_complete(bar, b.x, nloc, nx); b.st[0] = nloc; b.st[1] = nx; }
        const unsigned old = xb_add(&bar[XB_XSUB(b.x)], 1u);
        const unsigned gen = old / nloc;
        if (old + 1u == (gen + 1u) * nloc) {
            __builtin_amdgcn_fence(__ATOMIC_RELEASE, "agent");
            asm volatile("s_waitcnt vmcnt(0)" ::: "memory");
            const unsigned og = xb_add(&bar[XB_TOP], 1u);
            const unsigned tg = og / nx;
            if (og + 1u == (tg + 1u) * nx) xb_add(&bar[XB_TOPGEN], 1u);
            else XB_SPIN(xb_ld(&bar[XB_TOPGEN]) == tg, bar);
            __builtin_amdgcn_fence(__ATOMIC_ACQUIRE, "agent");
            xb_add(&bar[XB_XGEN(b.x)], 1u);
            asm volatile("s_waitcnt vmcnt(0)" ::: "memory");
        } else {
            XB_SPIN(xb_ld(&bar[XB_XGEN(b.x)]) == gen, bar);
            __builtin_amdgcn_fence(__ATOMIC_ACQUIRE, "agent");
            asm volatile("s_waitcnt vmcnt(0)" ::: "memory");
        }
    }
    __syncthreads();
}

#define GAS __attribute__((address_space(1)))
struct Args {
    const GAS float* in[28];
    GAS float* out; GAS unsigned char* ws;
    int ph_lo, ph_hi;
    int probe, G;
};
enum { I_X = 0, I_C, I_POS, I_NMG, I_NFG, I_WADA, I_BADA, I_WIN, I_LNG, I_LNB, I_GWS, I_GBS, I_QAG, I_WQUP, I_KVAG, I_WKVUP, I_QNG, I_KNG, I_ONG, I_WOUT,
       I_WR, I_RB, I_WEG, I_WEU, I_WED, I_WSG, I_WSU, I_WSD };

struct Frame {
    LAS unsigned char* lds;
    unsigned* ctl;
    unsigned char* ws;
    const __attribute__((address_space(4))) struct Args* ka;
    int tid, lane, wave, vcu, G;
};
typedef const __attribute__((address_space(4))) struct Args KArgs;
#define AIN(i) ((const float*)a.in[i])
extern __shared__ __attribute__((aligned(16))) unsigned char lds_raw[];
DI unsigned hw_wave_key() { return (unsigned)__builtin_amdgcn_s_getreg((5 << 11) | 4) & 63u; }
DI Frame frame_now() {
    Frame F;
    unsigned lb = (unsigned)(size_t)(LAS unsigned char*)lds_raw; asm volatile("" : "+s"(lb)); F.lds = (LAS unsigned char*)(size_t)lb;
    F.ka = (KArgs*)__builtin_amdgcn_kernarg_segment_ptr(); asm volatile("" : "+s"(F.ka));
    F.ws = (unsigned char*)F.ka->ws; F.ctl = (unsigned*)F.ws;
    F.G = F.ka->G; const int bx = (int)__builtin_amdgcn_workgroup_id_x(); F.vcu = (F.G % 8 == 0) ? (bx % 8) * (F.G / 8) + bx / 8 : bx;
    const unsigned wv = *(volatile LAS unsigned char*)(F.lds + LDSCTL_OFF + LC_WTAB + hw_wave_key());
    F.wave = __builtin_amdgcn_readfirstlane((int)wv);
    int ln = lane_id(); F.lane = ln; F.tid = F.wave * 64 + ln; return F; }
DI Frame launder(const Frame&) { return frame_now(); }
DI int launder_s(int x) { asm volatile("" : "+s"(x)); return x; }

DI void tr_item(const float* src, int N, bf16* dst, int ldk, const float* scale, int k0, int n0, int drow0, int dk0, LAS float* scr, int lane, int mode, size_t lo_off) {
    { f32x4 t[8];
#pragma unroll
      for (int i = 0; i < 8; ++i) t[i] = *(const f32x4*)(src + (size_t)(k0 + 8 * i + (lane >> 3)) * N + n0 + 4 * (lane & 7));
#pragma unroll
      for (int i = 0; i < 8; ++i) { const int kk = 8 * i + (lane >> 3); f32x4 v = t[i]; if (scale) v = v * scale[k0 + kk];
#pragma unroll
          for (int q = 0; q < 4; ++q) scr[kk * 33 + 4 * (lane & 7) + q] = v[q]; } }
    asm volatile("s_waitcnt lgkmcnt(0)" ::: "memory");
    const int c = lane & 7;
#pragma unroll
    for (int j = 0; j < 4; ++j) { const int n = (lane >> 3) + 8 * j; const LAS float* s = scr + (8 * c) * 33 + n;
        float v[8];
#pragma unroll
        for (int q = 0; q < 8; ++q) v[q] = s[q * 33];
        u32x4 o; o.x = pk2(v[0], v[1]); o.y = pk2(v[2], v[3]); o.z = pk2(v[4], v[5]); o.w = pk2(v[6], v[7]);
        bf16* dp = dst + (size_t)(drow0 + n) * ldk + dk0 + 8 * c;
        *(u32x4*)dp = o;
        if (mode == 1) {
            float r[8];
#pragma unroll
            for (int q = 0; q < 4; ++q) { r[2 * q] = v[2 * q] - bflo(o[q]); r[2 * q + 1] = v[2 * q + 1] - bfhi(o[q]); }
            u32x4 lo; lo.x = pk2(r[0], r[1]); lo.y = pk2(r[2], r[3]); lo.z = pk2(r[4], r[5]); lo.w = pk2(r[6], r[7]);
            *(u32x4*)(dp + lo_off) = lo;
        }
    }
    asm volatile("s_waitcnt lgkmcnt(0)" ::: "memory");
}

DI void tr_item8(const float* src, int N, unsigned char* dst8, int ldk, int k0, int n0, int drow0, int dk0, LAS float* scr, int lane, const float* scale = nullptr) {
    { f32x4 t[8];
#pragma unroll
      for (int i = 0; i < 8; ++i) t[i] = *(const f32x4*)(src + (size_t)(k0 + 8 * i + (lane >> 3)) * N + n0 + 4 * (lane & 7));
#pragma unroll
      for (int i = 0; i < 8; ++i) { const int kk = 8 * i + (lane >> 3); f32x4 v = t[i]; if (scale) v = v * scale[k0 + kk];
#pragma unroll
          for (int q = 0; q < 4; ++q) scr[kk * 33 + 4 * (lane & 7) + q] = v[q]; } }
    asm volatile("s_waitcnt lgkmcnt(0)" ::: "memory");
    const int c = lane & 7;
#pragma unroll
    for (int j = 0; j < 4; ++j) { const int n = (lane >> 3) + 8 * j; const LAS float* s_ = scr + (8 * c) * 33 + n;
        float v[8];
#pragma unroll
        for (int q = 0; q < 8; ++q) v[q] = s_[q * 33] * 64.0f;
        int p0 = __builtin_amdgcn_cvt_pk_fp8_f32(v[0], v[1], 0, false); p0 = __builtin_amdgcn_cvt_pk_fp8_f32(v[2], v[3], p0, true);
        int p1 = __builtin_amdgcn_cvt_pk_fp8_f32(v[4], v[5], 0, false); p1 = __builtin_amdgcn_cvt_pk_fp8_f32(v[6], v[7], p1, true);
        *(u32x2*)(dst8 + (size_t)(drow0 + n) * ldk + dk0 + 8 * c) = (u32x2){(unsigned)p0, (unsigned)p1}; }
    asm volatile("s_waitcnt lgkmcnt(0)" ::: "memory");
}

DI void conv_experts(const Frame& F0, int l, int it_lo, int it_hi, int part, int nparts) {
    const Frame F = launder(F0); KArgs& a = *F.ka; l = launder_s(l);
    LAS float* scr = (LAS float*)(F.lds + F.wave * 16384);
    const int gw = part * 8 + F.wave, NGW = nparts * 8;
    unsigned char* WGU8 = (unsigned char*)(F.ws + WS_WGU) + (size_t)l * WGU_L; unsigned char* WD8 = (unsigned char*)(F.ws + WS_WD) + (size_t)l * WD_L;
    for (int it = it_lo + gw; it < it_hi; it += NGW) {
        int e, r; if (it < NE1 * 256) { e = it >> 8; r = it & 255; } else { const int j = it - NE1 * 256; e = j >> 7; r = 256 + (j & 127); }
        const int kind = r >> 7, q = r & 127;
        if (kind < 2) {
            const float* src = (e < NE) ? (AIN(kind == 0 ? I_WEG : I_WEU) + ((size_t)l * NE + e) * 1024 * 256) : (AIN(kind == 0 ? I_WSG : I_WSU) + (size_t)l * 1024 * 256);
            const int kb = q >> 3, nb = q & 7, n0 = nb * 32;
            const int drow0 = (n0 >> 7) * 256 + kind * 128 + (n0 & 127);
            tr_item8(src, 256, WGU8 + (size_t)e * 512 * 1024, 1024, kb * 64, n0, drow0, kb * 64, scr, F.lane);
        } else {
            const float* src = (e < NE) ? (AIN(I_WED) + ((size_t)l * NE + e) * 256 * 1024) : (AIN(I_WSD) + (size_t)l * 256 * 1024);
            const int kb = q >> 5, nb = q & 31;
            tr_item8(src, 1024, WD8 + (size_t)e * 1024 * 256, 256, kb * 64, nb * 32, nb * 32, kb * 64, scr, F.lane);
        }
    }
}

DI void p0_prologue(const Frame& F0) {
    const Frame F = launder(F0); KArgs& a = *F.ka;
    const int tid = F.tid, lane = F.lane, wave = F.wave;
    {
        LAS float* cact = (LAS float*)F.lds;
        LAS float* red = (LAS float*)(F.lds + 32768);
        float* mod = (float*)(F.ws + WS_MOD);
        for (int it = blockIdx.x; it < 192; it += F.G) {
            const int l = it / 96, col0 = (it % 96) * 64;
            for (int i = tid; i < 8192; i += 512) { const float c = AIN(I_C)[i]; cact[i] = c / (1.f + expf(-c)); }
            __syncthreads();
            const int kg = tid >> 4, cq = tid & 15;
            float acc[8][4];
#pragma unroll
            for (int b = 0; b < 8; ++b)
#pragma unroll
                for (int j = 0; j < 4; ++j) acc[b][j] = 0.f;
            const float* wp = AIN(I_WADA) + (size_t)l * 1024 * 6144 + col0 + 4 * cq;
            for (int i = 0; i < 32; ++i) { const int k = kg + 32 * i; const f32x4 w = *(const f32x4*)(wp + (size_t)k * 6144);
#pragma unroll
                for (int b = 0; b < 8; ++b) { const float ca = cact[b * 1024 + k];
#pragma unroll
                    for (int j = 0; j < 4; ++j) acc[b][j] += ca * w[j]; } }
#pragma unroll
            for (int b = 0; b < 8; ++b)
#pragma unroll
                for (int j = 0; j < 4; ++j) { float v = acc[b][j]; v += shx(v, 16, lane); v += shx(v, 32, lane); if (lane < 16) red[wave * 512 + b * 64 + 4 * cq + j] = v; }
            __syncthreads();
            { float s = 0.f;
#pragma unroll
              for (int w = 0; w < 8; ++w) s += red[w * 512 + tid];
              const int b = tid >> 6, c = tid & 63;
              mod[((size_t)l * 8 + b) * 6144 + col0 + c] = s + AIN(I_BADA)[l * 6144 + col0 + c]; }
            __syncthreads();
        }
    }
    {
        float* cosT = (float*)(F.ws + WS_COS); float* sinT = (float*)(F.ws + WS_SIN);
        const int* pos = (const int*)AIN(I_POS);
        for (int i = F.vcu * 512 + tid; i < NTOK * 16; i += F.G * 512) {
            const int tok = i >> 4, fi = i & 15;
            double f = (fi & 3) == 0 ? 1.0 : ((fi & 3) == 1 ? 0.5623413251903491 : ((fi & 3) == 2 ? 0.31622776601683794 : 0.1778279410038923));
            const int dec = fi >> 2; f *= (dec == 0 ? 1.0 : (dec == 1 ? 0.1 : (dec == 2 ? 0.01 : 0.001)));
            const float invf = (float)f;
            const float angf = (float)pos[tok] * invf;
            const double ang = (double)angf;
            const double n = rint(ang * 0.15915494309189535);
            double r = fma(-n, 6.283185307179586, ang); r = fma(-n, 2.4492935982947064e-16, r);
            const double q = rint(r * 0.6366197723675814);
            double t = fma(-q, 1.5707963267948966, r); t = fma(-q, 6.123233995736766e-17, t);
            const double t2 = t * t;
            const double sn = t * (1.0 + t2 * (-1.0 / 6 + t2 * (1.0 / 120 + t2 * (-1.0 / 5040 + t2 * (1.0 / 362880 + t2 * (-1.0 / 39916800 + t2 * (1.0 / 6227020800.0)))))));
            const double cs = 1.0 + t2 * (-0.5 + t2 * (1.0 / 24 + t2 * (-1.0 / 720 + t2 * (1.0 / 40320 + t2 * (-1.0 / 3628800 + t2 * (1.0 / 479001600.0 + t2 * (-1.0 / 87178291200.0)))))));
            const int qi = ((int)q) & 3;
            const double c = qi == 0 ? cs : (qi == 1 ? -sn : (qi == 2 ? -cs : sn));
            const double s = qi == 0 ? sn : (qi == 1 ? cs : (qi == 2 ? -sn : -cs));
            cosT[i] = (float)c; sinT[i] = (float)s;
        }
    }
    {
        bf16* WS = (bf16*)(F.ws + WS_WS);
        for (int i = F.vcu * 512 + tid; i < 2 * 4 * 128 * 128; i += F.G * 512) { const int s = i & 127, t = (i >> 7) & 127; WS[i] = (s <= t) ? f2bf(AIN(I_GWS)[i]) : (bf16)0; }
        if (F.vcu == 0 && tid < 2) { float mq = 0.f, mk = 0.f;
#pragma unroll 1
            for (int d = 0; d < QKD; ++d) { mq = fmaxf(mq, fabsf(AIN(I_QNG)[tid * QKD + d])); mk = fmaxf(mk, fabsf(AIN(I_KNG)[tid * QKD + d])); }
            ((float*)(F.ws + WS_SMB))[tid] = 96.f * QSCALE * mq * mk * 1.03f + 0.25f; }
        bf16* WRT = (bf16*)(F.ws + WS_WR);
        for (int i = F.vcu * 512 + tid; i < 2 * 64 * 1024; i += F.G * 512) { const int l = i >> 16, r = i & 65535, e = r & 63, k = r >> 6;
            const float v = AIN(I_WR)[(size_t)l * 65536 + (size_t)k * 64 + e]; const unsigned short hi = f2bf(v), lo = f2bf(v - bf2f(hi));
            const size_t pos = ((size_t)((((k >> 7) * 8 + ((k >> 4) & 7)) * 2 + (e >> 5)) * 2) * 64 + ((k >> 3) & 1) * 32 + (e & 31)) * 8 + (k & 7);
            WRT[(size_t)l * 131072 + pos] = hi; WRT[(size_t)l * 131072 + pos + 512] = lo; }
        bf16* WIN = (bf16*)(F.ws + WS_WIN);
        for (int i = F.vcu * 512 + tid; i < 2 * 96 * 1024 / 8; i += F.G * 512) { const int l = i / (96 * 128), r = i % (96 * 128);
            *(u32x4*)(WIN + ((size_t)l * INP + INC) * 1024 + (size_t)r * 8) = (u32x4){0u, 0u, 0u, 0u}; }
    }
    __syncthreads();
    {
        LAS float* scr = (LAS float*)(F.lds + wave * 16384);
        const int gw = F.vcu * 8 + wave, NGW = F.G * 8;
        constexpr int N_IN = 16 * 53, N_Q = 6 * 24, N_KV = 4 * 32, N_OUT = 16 * 32, PER_L = N_IN + N_Q + N_KV + N_OUT;
        for (int it = gw; it < 2 * PER_L; it += NGW) {
            const int l = it / PER_L; int r = it % PER_L;
            if (r < N_IN) { const int kb = r / 53, nb = r % 53;
                tr_item(AIN(I_WIN) + (size_t)l * 1024 * INC, INC, (bf16*)(F.ws + WS_WIN) + (size_t)l * INP * 1024, 1024, nullptr, kb * 64, nb * 32, nb * 32, kb * 64, scr, lane, 0, 0); continue; }
            r -= N_IN;
            if (r < N_Q) { const int kb = r / 24, nb = r % 24;
                tr_item(AIN(I_WQUP) + (size_t)l * QL * 768, 768, (bf16*)(F.ws + WS_WQ) + (size_t)l * 768 * QL, QL, AIN(I_QAG) + l * QL, kb * 64, nb * 32, nb * 32, kb * 64, scr, lane, 0, 0); continue; }
            r -= N_Q;
            if (r < N_KV) { const int kb = r / 32, nb = r % 32;
                tr_item(AIN(I_WKVUP) + (size_t)l * KVL * 1024, 1024, (bf16*)(F.ws + WS_WKV) + (size_t)l * 1024 * KVL, KVL, AIN(I_KVAG) + l * KVL, kb * 64, nb * 32, nb * 32, kb * 64, scr, lane, 0, 0); continue; }
            r -= N_KV;
            if (r < N_OUT) { const int kb = r / 32, nb = r % 32;
                tr_item8(AIN(I_WOUT) + (size_t)l * 1024 * 1024, 1024, (unsigned char*)(F.ws + WS_WOUT) + (size_t)l * 1024 * 1024, 1024, kb * 64, nb * 32, nb * 32, (kb * 64 + 512) & 1023, scr, lane, AIN(I_ONG) + l * 1024); continue; }
        }
    }
    conv_experts(F, 0, 0, CONV_ITEMS, F.vcu, F.G);
}

DI void norm_row_store(const f32x4 (&v)[4], float rinv, const float* gw, const float* sc, const float* sh, bf16* orow, int lane) {
#pragma unroll
    for (int j = 0; j < 4; ++j) { const int c = 4 * lane + 256 * j;
        const f32x4 g = *(const f32x4*)(gw + c), s = *(const f32x4*)(sc + c), h = *(const f32x4*)(sh + c);
        const f32x4 o = v[j] * rinv * (g * (1.f + s)) + h;
        u32x2 w; w.x = pk2(o[0], o[1]); w.y = pk2(o[2], o[3]);
        *(u32x2*)(orow + c) = w; }
}
DI void norm1_phase(const Frame& F0, int l) {
    const Frame F = launder(F0); KArgs& a = *F.ka; l = launder_s(l);
    const float* X = AIN(I_X);
    const int gw = F.vcu * 8 + F.wave, NGW = F.G * 8;
    const float* mod = (const float*)(F.ws + WS_MOD) + (size_t)l * 8 * 6144;
    bf16* H = (bf16*)(F.ws + WS_H);
    for (int m0 = gw; m0 < NTOK; m0 += 2 * NGW) {
        const int m1 = m0 + NGW;
        f32x4 v0[4], v1[4]; float s0 = 0.f, s1 = 0.f;
#pragma unroll
        for (int j = 0; j < 4; ++j) v0[j] = *(const f32x4*)(X + (size_t)m0 * DM + 4 * F.lane + 256 * j);
        if (m1 < NTOK) {
#pragma unroll
            for (int j = 0; j < 4; ++j) v1[j] = *(const f32x4*)(X + (size_t)m1 * DM + 4 * F.lane + 256 * j); }
#pragma unroll
        for (int j = 0; j < 4; ++j) s0 += (v0[j].x * v0[j].x + v0[j].y * v0[j].y) + (v0[j].z * v0[j].z + v0[j].w * v0[j].w);
        { const float rinv = rsqrtf(wave_sum(s0, F.lane) * (1.f / DM) + EPS); const int b = m0 >> 12;
          norm_row_store(v0, rinv, AIN(I_NMG) + l * DM, mod + b * 6144 + 1024, mod + b * 6144, H + (size_t)m0 * DM, F.lane); }
        if (m1 < NTOK) {
#pragma unroll
            for (int j = 0; j < 4; ++j) s1 += (v1[j].x * v1[j].x + v1[j].y * v1[j].y) + (v1[j].z * v1[j].z + v1[j].w * v1[j].w);
            const float rinv = rsqrtf(wave_sum(s1, F.lane) * (1.f / DM) + EPS); const int b = m1 >> 12;
            norm_row_store(v1, rinv, AIN(I_NMG) + l * DM, mod + b * 6144 + 1024, mod + b * 6144, H + (size_t)m1 * DM, F.lane); }
    }
}

DI void mla_prep_unit(const Frame& F0, int l, int unit) {
    const Frame F = launder(F0); KArgs& a = *F.ka; l = launder_s(l);
    const int pmode = a.probe;
    const int lane = F.lane, w = F.wave, tid = F.tid, j31 = lane & 31, hf = lane >> 5;
    const int tile = unit >> 1, part = unit & 1;
    const int tok = tile * 256 + 32 * w + j31, b = (tile * 256) >> 12, s = tok & 4095;
    const bf16* LAT = (const bf16*)(F.ws + WS_LAT);
    const float* cosT = (const float*)(F.ws + WS_COS) + (size_t)tok * 16; const float* sinT = (const float*)(F.ws + WS_SIN) + (size_t)tok * 16;
    f32x4 cs[2], sn[2];
#pragma unroll
    for (int g = 0; g < 2; ++g) { cs[g] = *(const f32x4*)(cosT + 4 * hf + 8 * g); sn[g] = *(const f32x4*)(sinT + 4 * hf + 8 * g); }
    LAS unsigned char* wl = F.lds;
    if (part == 0) {
        const bf16* lrow = LAT + (size_t)tok * LATW + 8 * hf;
        bf16x8 bq[24]; float ss = 0.f;
#pragma unroll
        for (int ks = 0; ks < 24; ++ks) { bq[ks] = *(const bf16x8*)(lrow + 16 * ks);
#pragma unroll
            for (int q = 0; q < 8; ++q) { const float v = bf2f((unsigned short)bq[ks][q]); ss += v * v; } }
        ss += shx(ss, 32, lane);
        const float rq = rsqrtf(ss * (1.f / QL) + EPS);
        const bf16* WQ = (const bf16*)(F.ws + WS_WQ) + (size_t)l * 768 * QL;
        LAS float* gnl = (LAS float*)(F.lds + 130048);
        if (tid < QKD) gnl[tid] = AIN(I_QNG)[l * QKD + tid] * QSCALE;
        bf16* Qb = (bf16*)(F.ws + WS_Q);
        auto dmaq = [&](int hh, int ph) {
            LAS unsigned char* sb = wl + ph * 38400;
            const char* srcw = (const char*)(const GAS bf16*)uniform_ptr(WQ + (size_t)(hh * 96) * QL + ph * 192);
            int ln_ = lane; asm volatile("" : "+v"(ln_));
#pragma unroll
            for (int i = 0; i < 5; ++i) { const int inst = w + 8 * i;
                if (inst < 38) { const int c = inst * 64 + ln_; const int row = (c * 5243) >> 17, cc = c - row * 25;
                    const unsigned off = (unsigned)(row * QL + 8 * (cc > 23 ? 23 : cc)) * 2u;
                    if (c < 2400) __builtin_amdgcn_global_load_lds((const unsigned*)(srcw + off), (LAS unsigned*)(sb + inst * 1024), 16, 0, 0); } }
        };
        __syncthreads();
        dmaq(0, 0); dmaq(0, 1);
        for (int h = 0; h < NH; ++h) {
            f32x16 acc[3];
#pragma unroll
            for (int d = 0; d < 3; ++d) acc[d] = zero16();
            asm volatile("s_waitcnt vmcnt(0)" ::: "memory"); __syncthreads();
#pragma unroll
            for (int ks = 0; ks < 12; ++ks)
#pragma unroll
                for (int db = 0; db < 3; ++db) { const bf16x8 af = *(const LAS bf16x8*)(wl + (32 * db + j31) * 400 + (16 * ks + 8 * hf) * 2); acc[db] = MFMA32(af, bq[ks], acc[db]); if (db == 2 && (ks & 1)) asm volatile("" ::: "memory"); }
            __syncthreads();
            if (h + 1 < NH) dmaq(h + 1, 0);
#pragma unroll
            for (int ks = 0; ks < 12; ++ks)
#pragma unroll
                for (int db = 0; db < 3; ++db) { const bf16x8 af = *(const LAS bf16x8*)(wl + 38400 + (32 * db + j31) * 400 + (16 * ks + 8 * hf) * 2); acc[db] = MFMA32(af, bq[12 + ks], acc[db]); if (db == 2 && (ks & 1)) asm volatile("" ::: "memory"); }
            __syncthreads();
            if (h + 1 < NH) dmaq(h + 1, 1);
            float hs = 0.f;
#pragma unroll
            for (int db = 0; db < 3; ++db)
#pragma unroll
                for (int i = 0; i < 16; ++i) { acc[db][i] *= rq; hs += acc[db][i] * acc[db][i]; }
            hs += shx(hs, 32, lane);
            const float rn = rsqrtf(hs * (1.f / QKD) + EPS) ;
#pragma unroll
            for (int db = 0; db < 3; ++db)
#pragma unroll
                for (int g = 0; g < 4; ++g) { const f32x4 gn = *(const LAS f32x4*)(gnl + 32 * db + 4 * hf + 8 * g);
#pragma unroll
                    for (int r = 0; r < 4; ++r) acc[db][4 * g + r] *= rn * gn[r]; }
#pragma unroll
            for (int g = 0; g < 2; ++g)
#pragma unroll
                for (int r = 0; r < 4; ++r) { const float x1 = acc[2][4 * g + r], x2 = acc[2][4 * (g + 2) + r];
                    acc[2][4 * g + r] = x1 * cs[g][r] - x2 * sn[g][r]; acc[2][4 * (g + 2) + r] = x1 * sn[g][r] + x2 * cs[g][r]; }
            LAS unsigned char* tw = F.lds + 76800 + w * 6656;
#pragma unroll
            for (int db = 0; db < 3; ++db)
#pragma unroll
                for (int g = 0; g < 4; ++g) { u32x2 o; o.x = pk2(acc[db][4 * g], acc[db][4 * g + 1]); o.y = pk2(acc[db][4 * g + 2], acc[db][4 * g + 3]);
                    *(LAS u32x2*)(tw + j31 * 208 + (32 * db + 4 * hf + 8 * g) * 2) = o; }
            { bf16* qtile = Qb + ((size_t)(b * NH + h) * SEQ + (s - j31)) * QKD;
              int ln_ = lane; asm volatile("" : "+v"(ln_));
#pragma unroll
              for (int r = 0; r < 6; ++r) { const int c = ln_ + 64 * r, row = c / 12, part = c % 12;
                  const u32x4 v = *(const LAS u32x4*)(tw + row * 208 + part * 16);
                  if (pmode != 12) *(u32x4*)(qtile + (size_t)c * 8) = v; } }
        }
    } else {
        const bf16* lrow = LAT + (size_t)tok * LATW + QL + 8 * hf;
        bf16x8 bk[16]; float ss = 0.f;
#pragma unroll
        for (int ks = 0; ks < 16; ++ks) { bk[ks] = *(const bf16x8*)(lrow + 16 * ks);
#pragma unroll
            for (int q = 0; q < 8; ++q) { const float v = bf2f((unsigned short)bk[ks][q]); ss += v * v; } }
        ss += shx(ss, 32, lane);
        const float rkv = rsqrtf(ss * (1.f / KVL) + EPS);
        float pe[16]; float pss = 0.f;
#pragma unroll
        for (int g = 0; g < 4; ++g) { const u32x2 raw = *(const u32x2*)(LAT + (size_t)tok * LATW + 640 + 4 * hf + 8 * g);
            pe[4 * g] = bflo(raw.x); pe[4 * g + 1] = bfhi(raw.x); pe[4 * g + 2] = bflo(raw.y); pe[4 * g + 3] = bfhi(raw.y); }
#pragma unroll
        for (int i = 0; i < 16; ++i) pss += pe[i] * pe[i];
        const bf16* WKV = (const bf16*)(F.ws + WS_WKV) + (size_t)l * 1024 * KVL;
        LAS float* kng = (LAS float*)(F.lds + 130048);
        if (tid < QKD) kng[tid] = AIN(I_KNG)[l * QKD + tid];
        bf16* Kb = (bf16*)(F.ws + WS_K); bf16* Vt = (bf16*)(F.ws + WS_VT);
        auto dmak = [&](int hh, int ph) {
            LAS unsigned char* sb = wl + ph * 34816;
            const char* srcw = (const char*)(const GAS bf16*)uniform_ptr(WKV + (size_t)(hh * 128) * KVL + ph * 128);
            int ln_ = lane; asm volatile("" : "+v"(ln_));
#pragma unroll
            for (int i = 0; i < 5; ++i) { const int inst = w + 8 * i;
                if (inst < 34) { const int c = inst * 64 + ln_; const int row = (c * 3856) >> 16, cc = c - row * 17;
                    const unsigned off = (unsigned)(row * KVL + 8 * (cc > 15 ? 15 : cc)) * 2u;
                    __builtin_amdgcn_global_load_lds((const unsigned*)(srcw + off), (LAS unsigned*)(sb + inst * 1024), 16, 0, 0); } }
        };
        __syncthreads();
        dmak(0, 0); dmak(0, 1);
        for (int h = 0; h < NH; ++h) {
            f32x16 acc[4];
#pragma unroll
            for (int d = 0; d < 4; ++d) acc[d] = zero16();
            asm volatile("s_waitcnt vmcnt(0)" ::: "memory"); __syncthreads();
#pragma unroll
            for (int ks = 0; ks < 8; ++ks)
#pragma unroll
                for (int db = 0; db < 4; ++db) { const bf16x8 af = *(const LAS bf16x8*)(wl + (32 * db + j31) * 272 + (16 * ks + 8 * hf) * 2); acc[db] = MFMA32(af, bk[ks], acc[db]); if (db == 3 && (ks & 1)) asm volatile("" ::: "memory"); }
            __syncthreads();
            if (h + 1 < NH) dmak(h + 1, 0);
#pragma unroll
            for (int ks = 0; ks < 8; ++ks)
#pragma unroll
                for (int db = 0; db < 4; ++db) { const bf16x8 af = *(const LAS bf16x8*)(wl + 34816 + (32 * db + j31) * 272 + (16 * ks + 8 * hf) * 2); acc[db] = MFMA32(af, bk[8 + ks], acc[db]); if (db == 3 && (ks & 1)) asm volatile("" ::: "memory"); }
            __syncthreads();
            if (h + 1 < NH) dmak(h + 1, 1);
            float hs = pss;
#pragma unroll
            for (int db = 0; db < 2; ++db)
#pragma unroll
                for (int i = 0; i < 16; ++i) { acc[db][i] *= rkv; hs += acc[db][i] * acc[db][i]; }
            hs += shx(hs, 32, lane);
            const float rn = rsqrtf(hs * (1.f / QKD) + EPS);
            LAS unsigned char* tw = F.lds + 76800 + w * 6656;
#pragma unroll
            for (int db = 0; db < 2; ++db)
#pragma unroll
                for (int g = 0; g < 4; ++g) { const f32x4 gn = *(const LAS f32x4*)(kng + 32 * db + 4 * hf + 8 * g);
                    u32x2 o; o.x = pk2(acc[db][4 * g] * rn * gn[0], acc[db][4 * g + 1] * rn * gn[1]); o.y = pk2(acc[db][4 * g + 2] * rn * gn[2], acc[db][4 * g + 3] * rn * gn[3]);
                    *(LAS u32x2*)(tw + j31 * 208 + (32 * db + 4 * hf + 8 * g) * 2) = o; }
            float kp[16];
#pragma unroll
            for (int g = 0; g < 4; ++g) { const f32x4 gn = *(const LAS f32x4*)(kng + 64 + 4 * hf + 8 * g);
#pragma unroll
                for (int r = 0; r < 4; ++r) kp[4 * g + r] = pe[4 * g + r] * rn * gn[r]; }
#pragma unroll
            for (int g = 0; g < 2; ++g)
#pragma unroll
                for (int r = 0; r < 4; ++r) { const float x1 = kp[4 * g + r], x2 = kp[4 * (g + 2) + r];
                    kp[4 * g + r] = x1 * cs[g][r] - x2 * sn[g][r]; kp[4 * (g + 2) + r] = x1 * sn[g][r] + x2 * cs[g][r]; }
#pragma unroll
            for (int g = 0; g < 4; ++g) { u32x2 o; o.x = pk2(kp[4 * g], kp[4 * g + 1]); o.y = pk2(kp[4 * g + 2], kp[4 * g + 3]); *(LAS u32x2*)(tw + j31 * 208 + (64 + 4 * hf + 8 * g) * 2) = o; }
            { bf16* ktile = Kb + ((size_t)(b * NH + h) * SEQ + (s - j31)) * QKD;
              int ln_ = lane; asm volatile("" : "+v"(ln_));
#pragma unroll
              for (int r = 0; r < 6; ++r) { const int c = ln_ + 64 * r, row = c / 12, part = c % 12;
                  const u32x4 v = *(const LAS u32x4*)(tw + row * 208 + part * 16);
                  if (pmode != 12) *(u32x4*)(ktile + (size_t)c * 8) = v; } }
            bf16* vb_u = Vt + ((size_t)(b * NH + h) * VD) * SEQ;
            const int sp = (s & ~12) | ((s & 8) >> 1) | ((s & 4) << 1);
            const unsigned vlo = (unsigned)(4 * hf * SEQ + sp);
#pragma unroll
            for (int db = 0; db < 2; ++db)
#pragma unroll
                for (int i = 0; i < 16; ++i) { bf16* up = vb_u + (size_t)(32 * db + 8 * (i >> 2) + (i & 3)) * SEQ; if (pmode != 11 && pmode != 12) up[vlo] = f2bf(acc[2 + db][i] * rkv); }
        }
    }
    __syncthreads();
}

DI void gmlp_unit(const Frame& F0, int l, int unit) {
    const Frame F = launder(F0); KArgs& a = *F.ka; l = launder_s(l);
    const int lane = F.lane, w = F.wave, tid = F.tid, j31 = lane & 31, hf = lane >> 5;
    const int t0 = unit * 128;
    const bf16* UV = (const bf16*)(F.ws + WS_UV);
    unsigned char* MIX = (unsigned char*)(F.ws + WS_MIX);
    const bf16* WSb = (const bf16*)(F.ws + WS_WS) + (size_t)l * 4 * 128 * 128;
    LAS float* red = (LAS float*)(F.lds + 69632);
    const int tb = w & 3, cb0 = (w >> 2) * 2;
    LAS float* prm = (LAS float*)(F.lds + 70656);
    { prm[tid] = AIN(I_LNG)[l * 512 + tid]; prm[512 + tid] = AIN(I_LNB)[l * 512 + tid]; prm[1024 + tid] = AIN(I_GBS)[l * 512 + tid]; }
    float ssq = 0.f;
    u32x4 vraw[4];
    { const bf16* vp0 = UV + (size_t)(t0 + (tid >> 2)) * DM + 512 + 32 * (tid & 3);
#pragma unroll
      for (int q = 0; q < 4; ++q) vraw[q] = *(const u32x4*)(vp0 + 8 * q); }
    __syncthreads();
    for (int g = 0; g < 4; ++g) {
        LAS unsigned char* lv = F.lds + (g & 1) * 34816;
        {
            const int s = tid >> 2, cp = tid & 3;
            float x[32];
#pragma unroll
            for (int q = 0; q < 4; ++q) { const u32x4 raw = vraw[q];
#pragma unroll
                for (int e = 0; e < 4; ++e) { x[8 * q + 2 * e] = bflo(raw[e]); x[8 * q + 2 * e + 1] = bfhi(raw[e]); } }
            float sm = 0.f;
#pragma unroll
            for (int i = 0; i < 32; ++i) sm += x[i];
            sm += shx(sm, 1, lane); sm += shx(sm, 2, lane);
            const float mu = sm * (1.f / 128.f);
            float vq = 0.f;
#pragma unroll
            for (int i = 0; i < 32; ++i) { x[i] -= mu; vq += x[i] * x[i]; }
            vq += shx(vq, 1, lane); vq += shx(vq, 2, lane);
            const float rstd = rsqrtf(vq * (1.f / 128.f) + EPS);
            const LAS float* lg = prm + g * 128 + 32 * cp; const LAS float* lb = prm + 512 + g * 128 + 32 * cp;
#pragma unroll
            for (int i = 0; i < 32; ++i) { const float y = x[i] * rstd * lg[i] + lb[i]; *(LAS bf16*)(lv + (32 * cp + i) * 272 + s * 2) = f2bf(y); }
        }
        const int t = 32 * tb + j31;
        const bf16* up = UV + (size_t)(t0 + t) * DM + 128 * g + 32 * cb0 + 4 * hf;
        u32x2 ur_[2][4];
#pragma unroll
        for (int ci = 0; ci < 2; ++ci)
#pragma unroll
            for (int q = 0; q < 4; ++q) ur_[ci][q] = *(const u32x2*)(up + 32 * ci + 8 * q);
        if (g < 3) { const bf16* vpn = UV + (size_t)(t0 + (tid >> 2)) * DM + 512 + 128 * (g + 1) + 32 * (tid & 3);
#pragma unroll
            for (int q = 0; q < 4; ++q) vraw[q] = *(const u32x4*)(vpn + 8 * q); }
        __syncthreads();
        f32x16 acc[2]; acc[0] = zero16(); acc[1] = zero16();
        const bf16* wrow = WSb + ((size_t)g * 128 + 32 * tb + j31) * 128 + 8 * hf;
#pragma unroll
        for (int ks = 0; ks < 8; ++ks) {
            if (ks < 2 * (tb + 1)) {
                const bf16x8 bfr = *(const bf16x8*)(wrow + 16 * ks);
#pragma unroll
                for (int ci = 0; ci < 2; ++ci) { const bf16x8 af = *(const LAS bf16x8*)(lv + (32 * (cb0 + ci) + j31) * 272 + (16 * ks + 8 * hf) * 2); acc[ci] = MFMA32(af, bfr, acc[ci]); }
            }
        }
        const float bsv = prm[1024 + g * 128 + t];
        unsigned char* op = MIX + (size_t)(t0 + t) * DM + 512 + 128 * g + 32 * cb0 + 4 * hf;
#pragma unroll
        for (int ci = 0; ci < 2; ++ci)
#pragma unroll
            for (int q = 0; q < 4; ++q) { const u32x2 ur = ur_[ci][q];
                const float u0 = bflo(ur.x), u1 = bfhi(ur.x), u2 = bflo(ur.y), u3 = bfhi(ur.y);
                const float o0 = u0 * (acc[ci][4 * q] + bsv), o1 = u1 * (acc[ci][4 * q + 1] + bsv), o2 = u2 * (acc[ci][4 * q + 2] + bsv), o3 = u3 * (acc[ci][4 * q + 3] + bsv);
                ssq += (o0 * o0 + o1 * o1) + (o2 * o2 + o3 * o3);
                int ov = __builtin_amdgcn_cvt_pk_fp8_f32(o0 * 8.f, o1 * 8.f, 0, false); ov = __builtin_amdgcn_cvt_pk_fp8_f32(o2 * 8.f, o3 * 8.f, ov, true); *(unsigned*)(op + 32 * ci + 8 * q) = (unsigned)ov; }
    }
    ssq += shx(ssq, 32, lane);
    if (hf == 0) red[(w >> 2) * 128 + 32 * tb + j31] = ssq;
    __syncthreads();
    if (tid < 128) { const float v = red[tid] + red[128 + tid]; ((float*)(F.ws + WS_RGM))[t0 + tid] = rsqrtf(v * (1.f / 512.f) + EPS); }
    __syncthreads();
}

constexpr int AK_STRIDE = 208, AV_STRIDE = 144, AK_BYTES = 64 * AK_STRIDE, AV_BYTES = 64 * AV_STRIDE, ASLOT = AK_BYTES + AV_BYTES;
DI void attn_unit(const Frame& F0, int l, int b, int h, int qt) {
    const Frame F = launder(F0);
    const float nM = -((const float*)(F.ws + WS_SMB))[l];
    const int lane = F.lane, w = F.wave, tid = F.tid, j31 = lane & 31, hf = lane >> 5;
    const int bh = b * NH + h;
    const bf16* Qb = (const bf16*)(F.ws + WS_Q) + (size_t)bh * SEQ * QKD;
    const bf16* Kb = (const bf16*)(F.ws + WS_K) + (size_t)bh * SEQ * QKD;
    const bf16* Vt = (const bf16*)(F.ws + WS_VT) + (size_t)bh * VD * SEQ;
    const int qw = qt * 512 + 64 * w, cq = qt * 8 + w, ntiles = qt * 8 + 8;
    bf16x8 bq[2][6];
#pragma unroll
    for (int qb = 0; qb < 2; ++qb)
#pragma unroll
        for (int ds = 0; ds < 6; ++ds) bq[qb][ds] = *(const bf16x8*)(Qb + (size_t)(qw + 32 * qb + j31) * QKD + 16 * ds + 8 * hf);
    f32x16 O[2][2];
#pragma unroll
    for (int x = 0; x < 2; ++x)
#pragma unroll
        for (int y = 0; y < 2; ++y) O[x][y] = zero16();
    float lrun[2] = {0.f, 0.f};
    unsigned ko0, ko1, vo0, vo1;
    { const int c0 = tid, c1 = tid + 512; int r, p;
      r = c0 / 13; p = c0 % 13; ko0 = (unsigned)(r * QKD + 8 * (p > 11 ? 11 : p));
      r = c1 / 13; p = c1 % 13; if (r > 63) r = 63; ko1 = (unsigned)(r * QKD + 8 * (p > 11 ? 11 : p));
      r = c0 / 9; p = c0 % 9; vo0 = (unsigned)(r * SEQ + 8 * (p > 7 ? 7 : p));
      r = c1 / 9; p = c1 % 9; if (r > 63) r = 63; vo1 = (unsigned)(r * SEQ + 8 * (p > 7 ? 7 : p)); }
    auto dma = [&](int t, int slot) {
        LAS unsigned char* sb = F.lds + slot * ASLOT;
        const bf16* kt = Kb + (size_t)(64 * t) * QKD; const bf16* vt = Vt + 64 * t;
        __builtin_amdgcn_global_load_lds((const unsigned*)(kt + ko0), (LAS unsigned*)(sb + w * 1024), 16, 0, 0);
        if (w < 5) __builtin_amdgcn_global_load_lds((const unsigned*)(kt + ko1), (LAS unsigned*)(sb + 8192 + w * 1024), 16, 0, 0);
        __builtin_amdgcn_global_load_lds((const unsigned*)(vt + vo0), (LAS unsigned*)(sb + AK_BYTES + w * 1024), 16, 0, 0);
        if (w == 0) __builtin_amdgcn_global_load_lds((const unsigned*)(vt + vo1), (LAS unsigned*)(sb + AK_BYTES + 8192), 16, 0, 0);
    };
    __syncthreads();
    dma(0, 0);
    asm volatile("s_waitcnt vmcnt(0)" ::: "memory");
    __syncthreads();
    for (int t = 0; t < ntiles; ++t) {
        if (t + 1 < ntiles) dma(t + 1, (t + 1) & 1);
        if (t <= cq) {
            const LAS unsigned char* kb_ = F.lds + (t & 1) * ASLOT; const LAS unsigned char* vb_ = kb_ + AK_BYTES;
#pragma unroll
            for (int qb = 0; qb < 2; ++qb) {
                f32x16 S[2];
#pragma unroll
                for (int i = 0; i < 16; ++i) { S[0][i] = nM; S[1][i] = nM; }
#pragma unroll
                for (int ds = 0; ds < 6; ++ds)
#pragma unroll
                    for (int kb = 0; kb < 2; ++kb) { const bf16x8 af = *(const LAS bf16x8*)(kb_ + (32 * kb + j31) * AK_STRIDE + (16 * ds + 8 * hf) * 2);
                        S[kb] = MFMA32(af, bq[qb][ds], S[kb]); }
                float rs = 0.f;
                bf16x8 pf[2][2];
#pragma unroll
                for (int kb = 0; kb < 2; ++kb)
#pragma unroll
                    for (int s = 0; s < 2; ++s) { u32x4 p4;
#pragma unroll
                        for (int e = 0; e < 4; ++e) { const float p0 = __builtin_amdgcn_exp2f(S[kb][8 * s + 2 * e]), p1 = __builtin_amdgcn_exp2f(S[kb][8 * s + 2 * e + 1]);
                            rs += p0 + p1; p4[e] = pk2(p0, p1); }
                        pf[kb][s] = __builtin_bit_cast(bf16x8, p4); }
                lrun[qb] += rs;
#pragma unroll
                for (int kb = 0; kb < 2; ++kb)
#pragma unroll
                    for (int s = 0; s < 2; ++s) {
#pragma unroll
                        for (int db = 0; db < 2; ++db) {
                            const bf16x8 af = *(const LAS bf16x8*)(vb_ + (32 * db + j31) * AV_STRIDE + (32 * kb + 16 * s + 8 * hf) * 2);
                            O[db][qb] = MFMA32(af, pf[kb][s], O[db][qb]); }
                        if (s == 1) asm volatile("" ::: "memory");
                    }
                __builtin_amdgcn_sched_barrier(0);
            }
        }
        asm volatile("s_waitcnt vmcnt(0)" ::: "memory");
        __syncthreads();
    }
    unsigned char* MIX = (unsigned char*)(F.ws + WS_MIX); float* SSQ = (float*)(F.ws + WS_SSQ);
#pragma unroll
    for (int qb = 0; qb < 2; ++qb) {
        const float lt = lrun[qb] + shx(lrun[qb], 32, lane);
        const float inv = 1.f / lt;
        const int tok = b * SEQ + qw + 32 * qb + j31;
        float ss = 0.f;
#pragma unroll
        for (int db = 0; db < 2; ++db)
#pragma unroll
            for (int g = 0; g < 4; ++g) { float o[4];
#pragma unroll
                for (int r = 0; r < 4; ++r) { o[r] = O[db][qb][4 * g + r] * inv; ss += o[r] * o[r]; }
                int pk = __builtin_amdgcn_cvt_pk_fp8_f32(o[0] * 32.f, o[1] * 32.f, 0, false); pk = __builtin_amdgcn_cvt_pk_fp8_f32(o[2] * 32.f, o[3] * 32.f, pk, true);
                *(unsigned*)(MIX + (size_t)tok * DM + h * VD + 32 * db + 4 * hf + 8 * g) = (unsigned)pk; }
        ss += shx(ss, 32, lane);
        if (hf == 0) SSQ[(size_t)tok * 8 + h] = ss;
    }
}
DI void attn_phase(const Frame& F, int l) {
    for (int p = F.vcu; p < 256; p += F.G) {
        const int bh = p >> 2, j = p & 3;
#pragma unroll 1
        for (int k = 0; k < 2; ++k) attn_unit(F, l, bh >> 3, bh & 7, k ? j : 7 - j);
    }
}

struct EpiIn {
    static constexpr bool PERM = true, MID = false; static constexpr int HROWS = 128;
    static DI int bsrc(int R) { return (R & ~31) + pg8::perm32(R & 31); }
    bf16* UV; bf16* LAT;
    static constexpr int NST = 16, NPRE = 0;
    DI void prefetch(const pg8::Unit&, LAS unsigned char*, int, int) const {}
    DI void mid(f32x4 (&)[2][2][4][2], const pg8::Unit&, int, int) const {}
    DI void operator()(const f32x4 (&acc)[2][2][4][2], LAS unsigned char*, const pg8::Unit& u, int wr, int wc, int fr, int fq) const {
        const int row0 = u.pm * 256 + wr * 64 + fr;
        const bool act = u.pn < 4;
        bf16* base = act ? UV : LAT; const int ldc = act ? DM : LATW; const int col0 = (act ? u.pn : u.pn - 4) * 256 + wc * 32 + 8 * fq;
#pragma unroll
        for (int ai = 0; ai < 2; ++ai)
#pragma unroll
            for (int m = 0; m < 4; ++m) { bf16* rowp = base + (size_t)(row0 + ai * 128 + m * 16) * ldc + col0;
#pragma unroll
                for (int bj = 0; bj < 2; ++bj) { f32x4 v0 = acc[ai][bj][m][0], v1 = acc[ai][bj][m][1];
                    if (act) { const f32x2 a_ = pg8::gelu_pk((f32x2){v0[0], v0[1]}), b_ = pg8::gelu_pk((f32x2){v0[2], v0[3]}), c_ = pg8::gelu_pk((f32x2){v1[0], v1[1]}), d_ = pg8::gelu_pk((f32x2){v1[2], v1[3]});
                        v0 = (f32x4){a_.x, a_.y, b_.x, b_.y}; v1 = (f32x4){c_.x, c_.y, d_.x, d_.y}; }
                    u32x4 wv; wv.x = pk2(v0[0], v0[1]); wv.y = pk2(v0[2], v0[3]); wv.z = pk2(v1[0], v1[1]); wv.w = pk2(v1[2], v1[3]);
                    *(u32x4*)(rowp + bj * 128) = wv; } }
    }
};
struct EpiOut {
    static constexpr bool PERM = true, MID = (OUT_MID != 0); static constexpr int HROWS = 128;
    static DI int bsrc(int R) { return (R & ~31) + pg8::perm32(R & 31); }
    const float* xin32; const bf16* xin16; bf16* xout; const float* g1; const LAS float* tab;
    static constexpr int NST = -1, NPRE = 0;
    DI void prefetch(const pg8::Unit&, LAS unsigned char*, int, int) const {}
    DI void mid(f32x4 (&acc)[2][2][4][2], const pg8::Unit& u, int wr, int fr) const {
#pragma unroll
        for (int ai = 0; ai < 2; ++ai)
#pragma unroll
            for (int m = 0; m < 4; ++m) { const float sc = tab[u.e * 512 + ai * 128 + wr * 64 + m * 16 + fr];
#pragma unroll
                for (int bj = 0; bj < 2; ++bj)
#pragma unroll
                    for (int n = 0; n < 2; ++n) acc[ai][bj][m][n] = acc[ai][bj][m][n] * sc; }
    }
    DI void operator()(const f32x4 (&acc)[2][2][4][2], LAS unsigned char*, const pg8::Unit& u, int wr, int wc, int fr, int fq) const {
        const int row0 = u.pm * 256 + wr * 64 + fr, col0 = u.pn * 256 + wc * 32 + 8 * fq;
        const float* gb = g1 + (size_t)(row0 >> 12) * 6144 + col0;
        f32x4 gv[2][2];
#pragma unroll
        for (int bj = 0; bj < 2; ++bj)
#pragma unroll
            for (int n = 0; n < 2; ++n) gv[bj][n] = *(const f32x4*)(gb + bj * 128 + n * 4);
        const LAS float* tp = tab + u.e * 512 + 256 + wr * 64 + fr;
#pragma unroll
        for (int ai = 0; ai < 2; ++ai)
#pragma unroll
            for (int m = 0; m < 4; ++m) { const float rg = tp[ai * 128 + m * 16]; const size_t off = (size_t)(row0 + ai * 128 + m * 16) * DM + col0;
#pragma unroll
                for (int bj = 0; bj < 2; ++bj) { f32x4 x0, x1;
                    if (xin32) { x0 = *(const f32x4*)(xin32 + off + bj * 128); x1 = *(const f32x4*)(xin32 + off + bj * 128 + 4); }
                    else { const u32x4 r = *(const u32x4*)(xin16 + off + bj * 128); x0 = (f32x4){bflo(r.x), bfhi(r.x), bflo(r.y), bfhi(r.y)}; x1 = (f32x4){bflo(r.z), bfhi(r.z), bflo(r.w), bfhi(r.w)}; }
                    const f32x4 o0 = x0 + gv[bj][0] * (acc[ai][bj][m][0] * rg), o1 = x1 + gv[bj][1] * (acc[ai][bj][m][1] * rg);
                    u32x4 wv; wv.x = pk2(o0[0], o0[1]); wv.y = pk2(o0[2], o0[3]); wv.z = pk2(o1[0], o1[1]); wv.w = pk2(o1[2], o1[3]);
                    *(u32x4*)(xout + off + bj * 128) = wv; } }
    }
};
DI void outproj_tables(const Frame& F0, const pg8::DenseSched& S) {
    const Frame F = launder(F0);
    LAS float* tab = (LAS float*)(F.lds + LDSCTL_OFF + LC_UTAB);
    const float* ssq = (const float*)(F.ws + WS_SSQ); const float* rgm = (const float*)(F.ws + WS_RGM);
    pg8::Unit u;
#pragma unroll 1
    for (int i = 0; i < 7 && S.next(i, u); ++i) {
        if (F.tid < 256) { const int row = u.pm * 256 + F.tid;
            const f32x4 s0 = *(const f32x4*)(ssq + (size_t)row * 8), s1 = *(const f32x4*)(ssq + (size_t)row * 8 + 4);
            const float tot = ((s0[0] + s0[1]) + (s0[2] + s0[3])) + ((s1[0] + s1[1]) + (s1[2] + s1[3]));
            const float rg = rgm[row];
            tab[i * 512 + F.tid] = rsqrtf(tot * (1.f / 512.f) + EPS) / rg * 0.25f; tab[i * 512 + 256 + F.tid] = rg * (1.f / 512.f); }
    }
    __syncthreads();
}
template <bool GATHER>
struct MoeSched {
    static constexpr int NDMA = GATHER ? 1 : 0;
    const LAS u32x4* utab; int nmy; const u32x2* list; int half; int ptok;
    DI bool next(int i, pg8::Unit& u) const { if (i >= nmy) return false; const u32x4 v = utab[i];
        const int vx = __builtin_amdgcn_readfirstlane((int)v.x), vy = __builtin_amdgcn_readfirstlane((int)v.y), vz = __builtin_amdgcn_readfirstlane((int)v.z), vw = __builtin_amdgcn_readfirstlane((int)v.w);
        u.pm = vx; u.pn = vy & 0xffff; u.e = (int)((unsigned)vy >> 16); u.p0 = vz; u.cnt = vw; return true; }
    DI void a_offs(const pg8::Unit& u, int tid, int lda, unsigned (&o)[2][2]) const {
#pragma unroll
        for (int i = 0; i < 2; ++i) { int R, C; pg8::stage_rc(tid * 16 + i * 8192, R, C);
#pragma unroll
            for (int h = 0; h < 2; ++h) {
                if (GATHER) { const int p = min(u.p0 + h * 128 + R, u.cnt - 1);
                    const int tok = half * ptok + (int)(list[(size_t)u.e * ptok + p].x / 9u);
                    o[h][i] = (unsigned)(tok * lda + C) * 2u; }
                else o[h][i] = (unsigned)((u.pm * 256 + h * 128 + R) * lda + C) * 2u;
            } }
    }
    DI void dma_next(const pg8::Unit& u, LAS unsigned char* nx, int wid, int lane) const {
        if constexpr (GATHER) { const int p = min(u.p0 + (wid & 3) * 64 + lane, u.cnt - 1);
            __builtin_amdgcn_global_load_lds((const unsigned*)(list + (size_t)u.e * ptok + p), (LAS unsigned*)(nx + (wid & 3) * 256), 4, 0, 0); }
    }
    DI void offs_lds(LAS unsigned char* nx, int tid, int lda, unsigned (&o)[2][2]) const {
        if constexpr (GATHER) {
#pragma unroll
        for (int i = 0; i < 2; ++i) { int R, C; pg8::stage_rc(tid * 16 + i * 8192, R, C);
#pragma unroll
            for (int h = 0; h < 2; ++h) { const unsigned x = *(const LAS unsigned*)(nx + (h * 128 + R) * 4);
                o[h][i] = (unsigned)((half * ptok + (int)(x / 9u)) * lda + C) * 2u; } }
        }
    }
    DI size_t b_off(const pg8::Unit& u, int K) const { return GATHER ? ((size_t)u.e * 512 + u.pn * 256) * K * 2 : ((size_t)u.e * 1024 + u.pn * 256) * K * 2; }
};
struct EpiE1 {
    static constexpr bool PERM = true, MID = false; static constexpr int HROWS = 128;
    static DI int bsrc(int R) { return (R & ~31) + pg8::perm32(R & 31); }
    unsigned char* act; const u32x2* list; int ptok;
    static constexpr int NST = 8, NPRE = 2;
    DI void prefetch(const pg8::Unit& u, LAS unsigned char* pre, int wr, int lane) const {
#pragma unroll
        for (int ai = 0; ai < 2; ++ai) { const int p = min(u.p0 + ai * 128 + wr * 64 + lane, u.cnt - 1);
            __builtin_amdgcn_global_load_lds((const unsigned*)(list + (size_t)u.e * ptok + p) + 1, (LAS unsigned*)(pre + ai * 256), 4, 0, 0); }
    }
    DI void mid(f32x4 (&)[2][2][4][2], const pg8::Unit&, int, int) const {}
    DI void operator()(const f32x4 (&acc)[2][2][4][2], LAS unsigned char* pre, const pg8::Unit& u, int wr, int wc, int fr, int fq) const {
#pragma unroll
        for (int ai = 0; ai < 2; ++ai)
#pragma unroll
            for (int m = 0; m < 4; ++m) { const int r = ai * 128 + wr * 64 + m * 16 + fr;
                float wgt = *(const LAS float*)(pre + ai * 256 + (m * 16 + fr) * 4); if (u.p0 + r >= u.cnt) wgt = 0.f;
                const float wq = wgt * (1.f / 1024.f);
                float o[8];
#pragma unroll
                for (int n = 0; n < 2; ++n) { const f32x4 ga = acc[ai][0][m][n], ua = acc[ai][1][m][n];
                    const f32x4 arg = ga * (-1.4426950408889634f / 64.f);
                    f32x4 d;
#pragma unroll
                    for (int j = 0; j < 4; ++j) d[j] = __builtin_amdgcn_exp2f(arg[j]);
                    d = d + 1.0f;
                    f32x4 rc;
#pragma unroll
                    for (int j = 0; j < 4; ++j) rc[j] = __builtin_amdgcn_rcpf(d[j]);
                    const f32x4 ov = (ga * ua) * (rc * wq);
#pragma unroll
                    for (int j = 0; j < 4; ++j) o[4 * n + j] = ov[j]; }
                int p0 = __builtin_amdgcn_cvt_pk_fp8_f32(o[0], o[1], 0, false); p0 = __builtin_amdgcn_cvt_pk_fp8_f32(o[2], o[3], p0, true);
                int p1 = __builtin_amdgcn_cvt_pk_fp8_f32(o[4], o[5], 0, false); p1 = __builtin_amdgcn_cvt_pk_fp8_f32(o[6], o[7], p1, true);
                *(u32x2*)(act + (size_t)(u.pm * 256 + r) * FF + u.pn * 128 + wc * 32 + 8 * fq) = (u32x2){(unsigned)p0, (unsigned)p1}; }
    }
};
struct EpiE2 {
    static constexpr bool PERM = true, MID = false; static constexpr int HROWS = 8;
    static DI int bsrc(int R) { return 64 * ((R >> 5) & 3) + 16 * ((R >> 2) & 3) + 4 * ((R >> 4) & 1) + (R & 3); }
    unsigned char* y; const u32x2* list; int ptok;
    static constexpr int NST = 8, NPRE = 2;
    DI void prefetch(const pg8::Unit& u, LAS unsigned char* pre, int wr, int lane) const {
#pragma unroll
        for (int ai = 0; ai < 2; ++ai) { const int p = min(u.p0 + ai * 128 + wr * 64 + lane, u.cnt - 1);
            __builtin_amdgcn_global_load_lds((const unsigned*)(list + (size_t)u.e * ptok + p), (LAS unsigned*)(pre + ai * 256), 4, 0, 0); }
    }
    DI void mid(f32x4 (&)[2][2][4][2], const pg8::Unit&, int, int) const {}
    DI void operator()(const f32x4 (&acc)[2][2][4][2], LAS unsigned char* pre, const pg8::Unit& u, int wr, int wc, int fr, int fq) const {
#pragma unroll
        for (int ai = 0; ai < 2; ++ai)
#pragma unroll
            for (int m = 0; m < 4; ++m) { const int r = ai * 128 + wr * 64 + m * 16 + fr;
                unsigned dst = *(const LAS unsigned*)(pre + ai * 256 + (m * 16 + fr) * 4); if (u.p0 + r >= u.cnt) dst = (unsigned)(ptok * 9 + r);
                u32x4 wv;
#pragma unroll
                for (int bj = 0; bj < 2; ++bj)
#pragma unroll
                    for (int n = 0; n < 2; ++n) { const f32x4 v = acc[ai][bj][m][n] * (1.f / 32.f);
                        int p = __builtin_amdgcn_cvt_pk_fp8_f32(v[0], v[1], 0, false); p = __builtin_amdgcn_cvt_pk_fp8_f32(v[2], v[3], p, true); wv[2 * bj + n] = (unsigned)p; }
                __builtin_nontemporal_store(wv, (u32x4*)(y + (size_t)dst * DM + u.pn * 256 + wc * 64 + 16 * fq)); }
    }
};
DI int moe_build_table(const Frame& F0, int l, int half, int npn) {
    const Frame F = launder(F0);
    LAS int* tb = (LAS int*)(F.lds + LDSCTL_OFF + LC_TB); LAS int* cn = (LAS int*)(F.lds + LDSCTL_OFF + LC_CNT);
    LAS u32x4* utab = (LAS u32x4*)(F.lds + LDSCTL_OFF + LC_UTAB);
    __syncthreads();
    if (F.tid < NE1) cn[F.tid] = (F.tid < NE) ? (int)__hip_atomic_load(F.ctl + CW_CNT + ((l * 2 + half) * 64 + F.tid) * 16, __ATOMIC_RELAXED, __HIP_MEMORY_SCOPE_AGENT) : moe_ptok(l);
    __syncthreads();
    if (F.wave == 0) {
        const int lane = F.lane; const int c = cn[lane]; int t = (c + 255) >> 8;
#pragma unroll
        for (int o = 1; o < 64; o <<= 1) { const int t2 = __builtin_amdgcn_ds_bpermute((lane - o) << 2, t); if (lane >= o) t += t2; }
        tb[lane] = t - ((c + 255) >> 8);
        if (lane == 63) { tb[64] = t; tb[65] = t + ((moe_ptok(l) + 255) >> 8); }
    }
    __syncthreads();
    const int total = tb[NE1] * npn;
    const int c = F.vcu;
    const int nmy = (total > c) ? (total - c + F.G - 1) / F.G : 0;
    for (int i = F.tid; i < nmy; i += 512) {
        const int L = i * F.G + c; const int tile = L / npn, pn = L % npn;
        int lo = 0, hi = NE1;
#pragma unroll 1
        while (hi - lo > 1) { const int mid = (lo + hi) >> 1; if (tb[mid] <= tile) lo = mid; else hi = mid; }
        utab[i] = (u32x4){(unsigned)tile, (unsigned)pn | ((unsigned)lo << 16), (unsigned)((tile - tb[lo]) * 256), (unsigned)cn[lo]};
    }
    __syncthreads();
    return nmy;
}

#define DPP_F(v, ctrl) __builtin_bit_cast(float, __builtin_amdgcn_update_dpp(0, __builtin_bit_cast(int, (v)), (ctrl), 0xf, 0xf, true))
#define DPP_I(v, ctrl) __builtin_amdgcn_update_dpp(0, (v), (ctrl), 0xf, 0xf, true)
DI float max8(float v) { v = fmaxf(v, DPP_F(v, 0xB1)); v = fmaxf(v, DPP_F(v, 0x4E)); v = fmaxf(v, DPP_F(v, 0x141)); return v; }
DI int min8(int v) { v = min(v, DPP_I(v, 0xB1)); v = min(v, DPP_I(v, 0x4E)); v = min(v, DPP_I(v, 0x141)); return v; }
DI float sum64(float v) {
    v += DPP_F(v, 0xB1); v += DPP_F(v, 0x4E); v += DPP_F(v, 0x141); v += DPP_F(v, 0x140);
    const float a = __builtin_bit_cast(float, __builtin_amdgcn_readlane(__builtin_bit_cast(int, v), 0)), b = __builtin_bit_cast(float, __builtin_amdgcn_readlane(__builtin_bit_cast(int, v), 16)),
                c = __builtin_bit_cast(float, __builtin_amdgcn_readlane(__builtin_bit_cast(int, v), 32)), d = __builtin_bit_cast(float, __builtin_amdgcn_readlane(__builtin_bit_cast(int, v), 48));
    return (a + b) + (c + d); }
DI void router_phase(const Frame& F0, int l, const bool dry = false) {
    const Frame F = launder(F0); KArgs& a = *F.ka; l = launder_s(l);
    const int lane = F.lane, w = F.wave, tid = F.tid, j31 = lane & 31, hf = lane >> 5;
    const bf16* X1 = (const bf16*)(F.ws + WS_XB);
    unsigned char* H8 = (unsigned char*)(F.ws + WS_H8);
    const float* mod = (const float*)(F.ws + WS_MOD) + (size_t)l * 8 * 6144;
    const bf16* WRT = (const bf16*)(F.ws + WS_WR) + (size_t)l * 131072 + (size_t)w * 8 * 2048;
    const unsigned wlo = (unsigned)lane * 8u;
    LAS float* redA = (LAS float*)(F.lds);
    LAS float* part = (LAS float*)(F.lds + 4096);
    LAS float* logitA = (LAS float*)(F.lds + 4096 + 65536);
    LAS int* lcnt = (LAS int*)(F.lds + 4096 + 65536 + 33280);
    LAS unsigned* selA = (LAS unsigned*)(F.lds + 4096 + 65536 + 33280 + 512);
    LAS float* selW = (LAS float*)(F.lds + 4096 + 65536 + 33280 + 512 + 4096);
    LAS float* gvec = (LAS float*)(F.lds + 4096 + 65536 + 33280 + 512 + 8192);
    LAS float* svec = gvec + 1024;
    u32x2* LIST = (u32x2*)(F.ws + moe_list_off(l)); const int ptok = moe_ptok(l), psh = moe_shift(l);
    const float* rb = AIN(I_RB) + l * NE;
    const int pmode = dry ? 8 : a.probe;
    const int nun = (NTOK / 32 - F.vcu + F.G - 1) / F.G;
    f32x4 xv[8][2];
    auto load_x = [&](int unit) {
        const int tok = unit * 32 + j31;
#pragma unroll
        for (int st = 0; st < 8; ++st) { const u32x4 r = *(const u32x4*)(X1 + (size_t)tok * DM + 128 * w + 16 * st + 8 * hf);
            xv[st][0] = (f32x4){bflo(r.x), bfhi(r.x), bflo(r.y), bfhi(r.y)}; xv[st][1] = (f32x4){bflo(r.z), bfhi(r.z), bflo(r.w), bfhi(r.w)}; }
    };
    for (int u0 = 0; u0 < nun; u0 += 4) {
    const int ng = (nun - u0) < 4 ? (nun - u0) : 4;
    load_x(F.vcu + u0 * F.G);
    if (tid < 128) lcnt[tid] = 0;
    __syncthreads();
    for (int ug = 0; ug < ng; ++ug) {
        const int ui = u0 + ug, unit = F.vcu + ui * F.G;
        const int t0 = unit * 32, b = t0 >> 12;
        const int tok = t0 + j31;
        float ss = 0.f;
#pragma unroll
        for (int st = 0; st < 8; ++st)
#pragma unroll
            for (int q = 0; q < 2; ++q) ss += (xv[st][q].x * xv[st][q].x + xv[st][q].y * xv[st][q].y) + (xv[st][q].z * xv[st][q].z + xv[st][q].w * xv[st][q].w);
        ss += shx(ss, 32, lane);
        if (hf == 0) redA[w * 32 + j31] = ss;
        { const int c2 = 2 * tid; const f32x2 g = *(const f32x2*)(AIN(I_NFG) + l * DM + c2), sc = *(const f32x2*)(mod + b * 6144 + 4096 + c2), sh = *(const f32x2*)(mod + b * 6144 + 3072 + c2);
          *(LAS f32x2*)(gvec + c2) = g * (1.f + sc); *(LAS f32x2*)(svec + c2) = sh; }
        __syncthreads();
        float tot = 0.f;
#pragma unroll
        for (int q = 0; q < 8; ++q) tot += redA[q * 32 + j31];
        const float rinv = rsqrtf(tot * (1.f / DM) + EPS);
        f32x16 acc[2]; acc[0] = zero16(); acc[1] = zero16();
        if (pmode != 6 && pmode != 7) {
            bf16x8 Bh[8][2], Bl[8][2];
            auto ldB = [&](int st) {
#pragma unroll
                for (int eb = 0; eb < 2; ++eb) { const bf16* fp = (const bf16*)(const GAS bf16*)uniform_ptr(WRT + st * 2048 + eb * 1024); Bh[st][eb] = *(const bf16x8*)(fp + wlo); Bl[st][eb] = *(const bf16x8*)(fp + 512 + wlo); } };
            ldB(0); ldB(1);
#pragma unroll
            for (int st = 0; st < 8; ++st) { const int col = 128 * w + 16 * st + 8 * hf;
                if (st + 2 < 8) ldB(st + 2);
                asm volatile("" ::: "memory");
                float hv[8];
#pragma unroll
                for (int q = 0; q < 2; ++q) { const f32x4 g = *(const LAS f32x4*)(gvec + col + 4 * q), sh = *(const LAS f32x4*)(svec + col + 4 * q);
                    const f32x4 o = xv[st][q] * rinv * g + sh;
#pragma unroll
                    for (int e = 0; e < 4; ++e) hv[4 * q + e] = o[e]; }
                u32x4 hi4, lo4;
#pragma unroll
                for (int e = 0; e < 4; ++e) { hi4[e] = pk2(hv[2 * e], hv[2 * e + 1]); lo4[e] = pk2(hv[2 * e] - bflo(hi4[e]), hv[2 * e + 1] - bfhi(hi4[e])); }
                if (pmode != 14) { int q0 = __builtin_amdgcn_cvt_pk_fp8_f32(hv[0], hv[1], 0, false); q0 = __builtin_amdgcn_cvt_pk_fp8_f32(hv[2], hv[3], q0, true);
                    int q1 = __builtin_amdgcn_cvt_pk_fp8_f32(hv[4], hv[5], 0, false); q1 = __builtin_amdgcn_cvt_pk_fp8_f32(hv[6], hv[7], q1, true);
                    *(u32x2*)(H8 + (size_t)tok * DM + col) = (u32x2){(unsigned)q0, (unsigned)q1}; }
                const bf16x8 ahi = __builtin_bit_cast(bf16x8, hi4), alo = __builtin_bit_cast(bf16x8, lo4);
                if (pmode != 15)
#pragma unroll
                for (int eb = 0; eb < 2; ++eb) { acc[eb] = MFMA32(ahi, Bh[st][eb], acc[eb]); acc[eb] = MFMA32(alo, Bh[st][eb], acc[eb]); acc[eb] = MFMA32(ahi, Bl[st][eb], acc[eb]); }
            }
        }
        if (ug + 1 < ng) load_x(unit + F.G);
#pragma unroll
        for (int eb = 0; eb < 2; ++eb)
#pragma unroll
            for (int i = 0; i < 16; ++i) part[w * 2048 + (4 * hf + 8 * (i >> 2) + (i & 3)) * 64 + 32 * eb + j31] = acc[eb][i];
        __syncthreads();
#pragma unroll
        for (int q = 0; q < 4; ++q) { const int idx = tid + 512 * q; float s_ = 0.f;
#pragma unroll
            for (int ww = 0; ww < 8; ++ww) s_ += part[ww * 2048 + idx];
            logitA[(ug * 32 + (idx >> 6)) * 65 + (idx & 63)] = s_; }
    }
    __syncthreads();
    if (w < ng && lane < 32 && !(pmode == 5 || pmode == 7)) {
        int ln2 = lane; asm volatile("" : "+v"(ln2));
        const int ui = u0 + w, t = (F.vcu + ui * F.G) * 32 + ln2, half = t >> psh;
        const LAS float* lrow = logitA + (w * 32 + ln2) * 65;
        float m[64];
#pragma unroll
        for (int e = 0; e < 64; ++e) m[e] = __builtin_amdgcn_rcpf(1.f + __builtin_amdgcn_exp2f(-1.4426950408889634f * lrow[e])) + rb[e];
        float gs[8];
#pragma unroll
        for (int g = 0; g < 8; ++g) { float hi = -INFINITY, lo = -INFINITY;
#pragma unroll
            for (int i = 0; i < 8; ++i) { const float v = m[8 * g + i]; lo = fmaxf(lo, fminf(hi, v)); hi = fmaxf(hi, v); }
            gs[g] = hi + lo; }
#pragma unroll
        for (int g = 0; g < 8; ++g) { int r = 0;
#pragma unroll
            for (int g2 = 0; g2 < 8; ++g2) r += (gs[g2] > gs[g] || (gs[g2] == gs[g] && g2 < g)) ? 1 : 0;
            if (r >= 4) {
#pragma unroll
                for (int i = 0; i < 8; ++i) m[8 * g + i] = -INFINITY; } }
        int ei[8]; float sv[8]; float wsum = 0.f;
#pragma unroll
        for (int r = 0; r < 8; ++r) {
            float mx = m[0];
#pragma unroll
            for (int e = 1; e < 64; ++e) mx = fmaxf(mx, m[e]);
            int idx = 0;
#pragma unroll
            for (int e = 63; e >= 0; --e) idx = (m[e] == mx) ? e : idx;
#pragma unroll
            for (int e = 0; e < 64; ++e) m[e] = (e == idx) ? -INFINITY : m[e];
            const float val = __builtin_amdgcn_rcpf(1.f + __builtin_amdgcn_exp2f(-1.4426950408889634f * lrow[idx]));
            ei[r] = idx; sv[r] = val; wsum += val;
        }
        const float wn = 2.5f / wsum;
#pragma unroll
        for (int r = 0; r < 8; ++r) if (pmode != 8) {
            const int pl = __hip_atomic_fetch_add(lcnt + half * 64 + ei[r], 1, __ATOMIC_RELAXED, __HIP_MEMORY_SCOPE_WORKGROUP);
            const int slot = (w * 32 + ln2) * 8 + r;
            selA[slot] = (unsigned)ei[r] | ((unsigned)r << 8) | ((unsigned)pl << 16); selW[slot] = sv[r] * wn; }
    }
    __syncthreads();
    if (tid < 128 && pmode != 8) { const int c = lcnt[tid]; int gb = 0; if (c > 0) gb = (int)__hip_atomic_fetch_add(F.ctl + CW_CNT + ((l * 2 + (tid >> 6)) * 64 + (tid & 63)) * 16, (unsigned)c, __ATOMIC_RELAXED, __HIP_MEMORY_SCOPE_AGENT); lcnt[tid] = gb; }
    __syncthreads();
    for (int i = tid; i < ((pmode == 5 || pmode == 7 || pmode == 8) ? 0 : ng * 256); i += 512) {
        const int ug = i >> 8, tl = (i >> 3) & 31; const unsigned pa = selA[i]; const int e = pa & 0xff, rank = (pa >> 8) & 0xff, pl = pa >> 16;
        const int t = (F.vcu + (u0 + ug) * F.G) * 32 + tl, half = t >> psh, tk = t - half * ptok;
        LIST[((size_t)half * NE1 + e) * ptok + lcnt[half * 64 + e] + pl] = (u32x2){(unsigned)(tk * 9 + rank), __float_as_uint(selW[i])}; }
    for (int i = tid; i < (pmode == 8 ? 0 : ng * 32); i += 512) { const int t = (F.vcu + (u0 + (i >> 5)) * F.G) * 32 + (i & 31), half = t >> psh, tk = t - half * ptok;
        LIST[((size_t)half * NE1 + NE) * ptok + tk] = (u32x2){(unsigned)(tk * 9 + 8), __float_as_uint(1.0f)}; }
    __syncthreads();
    }
}

DI void combine_phase(const Frame& F0, int l, int half, bool probe = false) {
    const Frame F = launder(F0); KArgs& a = *F.ka; l = launder_s(l);
    const int gw = F.vcu * 8 + F.wave, NGW = F.G * 8, lane = F.lane;
    const float* mod = (const float*)(F.ws + WS_MOD) + (size_t)l * 8 * 6144;
    const float* modn = (const float*)(F.ws + WS_MOD) + (size_t)(l + 1) * 8 * 6144;
    const unsigned char* Y = (const unsigned char*)(F.ws + moe_y_off(l)); const int ptok = moe_ptok(l);
    bf16* H = (bf16*)(F.ws + WS_H);
    const bf16* XB = (const bf16*)(F.ws + WS_XB); float* XF = ((float*)a.out);
    bf16* XO = probe ? (bf16*)(F.ws + WS_Y + 150 * MiB) : (bf16*)(F.ws + WS_XB); bf16* HO = probe ? (bf16*)(F.ws + WS_Y + 220 * MiB) : H;
    for (int ml = gw; ml < ptok; ml += NGW) {
        const int m = half * ptok + ml, b = m >> 12;
        f32x2 sacc[8];
#pragma unroll
        for (int q = 0; q < 8; ++q) sacc[q] = (f32x2){0.f, 0.f};
#pragma unroll
        for (int k = 0; k < 9; ++k) { const u32x4 raw = *(const u32x4*)(Y + ((size_t)ml * 9 + k) * DM + 16 * lane);
#pragma unroll
            for (int e = 0; e < 4; ++e) { sacc[2 * e] += __builtin_amdgcn_cvt_pk_f32_fp8((int)raw[e], false); sacc[2 * e + 1] += __builtin_amdgcn_cvt_pk_f32_fp8((int)raw[e], true); } }
        f32x4 xn[4]; float ss = 0.f;
        const u32x4 xr0 = *(const u32x4*)(XB + (size_t)m * DM + 16 * lane), xr1 = *(const u32x4*)(XB + (size_t)m * DM + 16 * lane + 8);
#pragma unroll
        for (int q = 0; q < 4; ++q) { const int c = 16 * lane + 4 * q;
            const unsigned wa = (q < 2 ? xr0 : xr1)[2 * (q & 1)], wb = (q < 2 ? xr0 : xr1)[2 * (q & 1) + 1];
            const f32x4 xv = (f32x4){bflo(wa), bfhi(wa), bflo(wb), bfhi(wb)}, g2 = *(const f32x4*)(mod + b * 6144 + 5120 + c);
            const f32x4 sv = (f32x4){sacc[2 * q].x, sacc[2 * q].y, sacc[2 * q + 1].x, sacc[2 * q + 1].y} * 0.125f;
            const f32x4 o = xv + g2 * sv; xn[q] = o;
            if (l == 1 && !probe) *(f32x4*)(XF + (size_t)m * DM + c) = o;
            ss += (o.x * o.x + o.y * o.y) + (o.z * o.z + o.w * o.w); }
        if (l == 0 || probe) { u32x4 w0, w1; w0.x = pk2(xn[0][0], xn[0][1]); w0.y = pk2(xn[0][2], xn[0][3]); w0.z = pk2(xn[1][0], xn[1][1]); w0.w = pk2(xn[1][2], xn[1][3]);
            w1.x = pk2(xn[2][0], xn[2][1]); w1.y = pk2(xn[2][2], xn[2][3]); w1.z = pk2(xn[3][0], xn[3][1]); w1.w = pk2(xn[3][2], xn[3][3]);
            *(u32x4*)(XO + (size_t)m * DM + 16 * lane) = w0; *(u32x4*)(XO + (size_t)m * DM + 16 * lane + 8) = w1; }
        if (l == 0 || probe) {
            const float rinv = rsqrtf(wave_sum(ss, F.lane) * (1.f / DM) + EPS);
            u32x4 wv[2];
#pragma unroll
            for (int q = 0; q < 4; ++q) { const int c = 16 * lane + 4 * q;
                const f32x4 g = *(const f32x4*)(AIN(I_NMG) + DM + c), sc = *(const f32x4*)(modn + b * 6144 + 1024 + c), sh = *(const f32x4*)(modn + b * 6144 + c);
                const f32x4 o = xn[q] * rinv * (g * (1.f + sc)) + sh;
                wv[q >> 1][2 * (q & 1)] = pk2(o[0], o[1]); wv[q >> 1][2 * (q & 1) + 1] = pk2(o[2], o[3]); }
            *(u32x4*)(HO + (size_t)m * DM + 16 * lane) = wv[0]; *(u32x4*)(HO + (size_t)m * DM + 16 * lane + 8) = wv[1];
        }
    }
}

DI void grid_sync(const Frame& F0) {
    const Frame F = launder(F0);
    XcdBarrier b; b.bar = F.ctl + CW_BAR; b.x = xb_xcc_id(); b.st = (volatile LAS unsigned*)(F.lds + LDSCTL_OFF + LC_BAR);
    xcd_barrier(b, F.wave);
}
constexpr int NPHASE = 2 + 2 * 11;
#ifndef PHASE_MASK
#define PHASE_MASK 0xFFFF
#endif
#define PM(i) ((PHASE_MASK >> (i)) & 1)
#define KA_NOW ((KArgs*)__builtin_amdgcn_kernarg_segment_ptr())
#define IN(k) (N_LAUNCH_MODE == 1 || (KA_NOW->ph_lo <= (k) && (k) < KA_NOW->ph_hi))
DI int rfl(int x) { return __builtin_amdgcn_readfirstlane(x); }
DI void ph_sync() { const Frame F = frame_now(); grid_sync(F); }
DI void ph_prologue() { const Frame F = frame_now(); p0_prologue(F); }
DI void ph_norm1() { const Frame F = frame_now(); norm1_phase(F, 0); }
DI void ph_inproj(int l) { const Frame F = frame_now(); l = launder_s(rfl(l));
    pg8::DenseSched S; S.init(NTOK, INP, F.G, (int)blockIdx.x);
    EpiIn E{(bf16*)(F.ws + WS_UV), (bf16*)(F.ws + WS_LAT)};
    pg8::gemm_phase<EpiIn, pg8::DenseSched>(F.lds, F.wave, (const bf16*)(F.ws + WS_H), (const bf16*)(F.ws + WS_WIN) + (size_t)l * INP * 1024, 1024, 1024, S, E);
    { const int rem = S.nwg % F.G; const int c = (int)blockIdx.x;
      if (rem > 0 && c >= rem) { __syncthreads(); conv_experts(F, 1, l * CONV_TAIL, (l + 1) * CONV_TAIL, c - rem, F.G - rem); } } }
DI void ph_mla(int l) { const Frame F = frame_now();
#pragma unroll 1
    for (int u = F.vcu; u < 256; u += F.G) mla_prep_unit(F, rfl(l), u); }
DI void ph_gmlp(int l) { const Frame F = frame_now();
#pragma unroll 1
    for (int u = F.vcu; u < 256; u += F.G) gmlp_unit(F, rfl(l), u); }
DI void ph_conv(int l) { const Frame F = frame_now();
    const int rem = ((NTOK / 256) * (INP / 256)) % F.G; const int lo = rem > 0 ? 2 * CONV_TAIL : 0;
    if (lo < CONV_E1LO) conv_experts(F, rfl(l), lo, CONV_E1LO, F.vcu, F.G);
    conv_experts(F, rfl(l), CONV_E1HI, CONV_ITEMS, F.vcu, F.G); }
DI void ph_attn(int l) { const Frame F = frame_now(); attn_phase(F, rfl(l)); }
DI void ph_outproj(int l) { const Frame F = frame_now(); l = launder_s(rfl(l));
    const float* modl = (const float*)(F.ws + WS_MOD) + (size_t)l * 8 * 6144;
    pg8::DenseSched S; S.init(NTOK, DM, F.G, (int)blockIdx.x);
    outproj_tables(F, S);
    bf16* XB = (bf16*)(F.ws + WS_XB);
    EpiOut E{l == 0 ? ((const float*)F.ka->in[I_X]) : (const float*)nullptr, XB, F.ka->probe ? (bf16*)(F.ws + WS_Y + 150 * MiB) : XB, modl + 2048, (const LAS float*)(F.lds + LDSCTL_OFF + LC_UTAB)};
    pg8::gemm_phase<EpiOut, pg8::DenseSched, true, false, true>(F.lds, F.wave, (const bf16*)(F.ws + WS_MIX), (const bf16*)(F.ws + WS_WOUT + (size_t)l * 1024 * 1024), 512, 512, S, E); }
DI void ph_router(int l) { const Frame F = frame_now(); router_phase(F, rfl(l)); }
DI void ph_router_dry(int l) { const Frame F = frame_now(); router_phase(F, rfl(l), true); }
DI void ph_e1(int l, int half) { const Frame F = frame_now(); l = launder_s(rfl(l)); half = launder_s(rfl(half));
    const int ptok = moe_ptok(l);
    const u32x2* list = (const u32x2*)(F.ws + moe_list_off(l)) + (size_t)half * NE1 * ptok;
    const int nmy = moe_build_table(F, l, half, 2);
    MoeSched<true> S{(const LAS u32x4*)(F.lds + LDSCTL_OFF + LC_UTAB), nmy, list, half, ptok};
    EpiE1 E{(unsigned char*)(F.ws + moe_act_off(l)), list, ptok};
    pg8::gemm_phase<EpiE1, MoeSched<true>, true, false, true>(F.lds, F.wave, (const bf16*)(F.ws + WS_H8), (const bf16*)(F.ws + WS_WGU + (size_t)l * WGU_L), 512, 512, S, E);
    if (l == 0) {
        const int total = ((const LAS int*)(F.lds + LDSCTL_OFF + LC_TB))[NE1] * 2, rem = total % F.G;
        __syncthreads();
        if (rem == 0) conv_experts(F, 1, CONV_E1LO, CONV_E1HI, F.vcu, F.G);
        else if (F.vcu >= rem) conv_experts(F, 1, CONV_E1LO, CONV_E1HI, F.vcu - rem, F.G - rem); } }
DI void ph_e2(int l, int half) { const Frame F = frame_now(); l = launder_s(rfl(l)); half = launder_s(rfl(half));
    const int ptok = moe_ptok(l);
    const u32x2* list = (const u32x2*)(F.ws + moe_list_off(l)) + (size_t)half * NE1 * ptok;
    const int nmy = moe_build_table(F, l, half, 4);
    MoeSched<false> S{(const LAS u32x4*)(F.lds + LDSCTL_OFF + LC_UTAB), nmy, list, half, ptok};
    EpiE2 E{(unsigned char*)(F.ws + moe_y_off(l)), list, ptok};
    pg8::gemm_phase<EpiE2, MoeSched<false>, true, true>(F.lds, F.wave, (const bf16*)(F.ws + moe_act_off(l)), (const bf16*)(F.ws + WS_WD + (size_t)l * WD_L), 128, 128, S, E); }
DI void ph_combine(int l, int half) { const Frame F = frame_now(); combine_phase(F, rfl(l), rfl(half), F.ka->probe != 0); }

__global__ void __launch_bounds__(512, 2) trunk_fwd(Args args) {
    Frame F;
    {
        LAS unsigned char* lds0 = (LAS unsigned char*)lds_raw;
        for (int u = (int)threadIdx.x; u < (LDS_BYTES - LDSCTL_OFF) / 4; u += 512) ((LAS unsigned*)(lds0 + LDSCTL_OFF))[u] = 0u;
        __syncthreads();
        if ((threadIdx.x & 63) == 0) *(volatile LAS unsigned char*)(lds0 + LDSCTL_OFF + LC_WTAB + hw_wave_key()) = (unsigned char)(threadIdx.x >> 6);
        __syncthreads();
        F = frame_now();
        if (N_LAUNCH_MODE == 1) (void)xcd_barrier_post(F.ctl + CW_BAR, (volatile LAS unsigned*)(F.lds + LDSCTL_OFF + LC_BAR));
    }
#define SEAMK() do { if (N_LAUNCH_MODE == 1) ph_sync(); } while (0)
    if (PM(0) && IN(0)) ph_prologue();
    SEAMK();
    if (PM(1) && IN(1)) ph_norm1();
    SEAMK();
#pragma unroll 1
    for (int l = 0; l < 2; ++l) {
        const int pb = 2 + 11 * l;
        if (PM(2) && IN(pb + 0)) ph_inproj(l);
        SEAMK();
        if (PM(3) && IN(pb + 1)) {
            int par; { const Frame Fp = frame_now(); par = (Fp.vcu >> 1) & 1; }
#pragma unroll 1
            for (int k = 0; k < 2; ++k) {
                if ((k ^ par) == 0) { if (KA_NOW->probe == 0 || KA_NOW->probe == 2 || (KA_NOW->probe >= 11 && KA_NOW->probe <= 13)) ph_mla(l); }
                else { if (KA_NOW->probe == 0 || KA_NOW->probe == 3) ph_gmlp(l); }
            }
            if (l == 1 && (KA_NOW->probe == 0 || KA_NOW->probe == 4)) ph_conv(1);
        }
        SEAMK();
        if (PM(4) && IN(pb + 2)) ph_attn(l);
        SEAMK();
        if (PM(5) && IN(pb + 3)) ph_outproj(l);
        SEAMK();
        if (PM(6) && IN(pb + 4)) ph_router(l);
        SEAMK();
#if defined(ROUTER_DRY_REPS)
#pragma unroll 1
        for (int r = 0; r < ROUTER_DRY_REPS; ++r) { ph_router_dry(l); SEAMK(); }
#endif
#pragma unroll 1
        for (int half = 0; half < 1; ++half) {
            const int ph = pb + 5 + 3 * half;
            if (PM(7) && IN(ph)) ph_e1(l, half);
            SEAMK();
            if (PM(8) && IN(ph + 1)) ph_e2(l, half);
            SEAMK();
            if (PM(9) && IN(ph + 2)) ph_combine(l, half);
            if (l == 0) SEAMK();
        }
    }
#if defined(EXTRA_SYNCS)
#pragma unroll 1
    for (int r = 0; r < EXTRA_SYNCS; ++r) SEAMK();
#endif
#undef IN
}

extern "C" void kernel_launch(void* const* d_in, const int* in_sizes, int n_in, void* d_out, int out_size, void* d_ws, size_t ws_size, hipStream_t stream) {
    static int grid = 0;
    if (grid == 0) {
        if (n_in != 28 || out_size != NTOK * DM || ws_size < WS_END) { fprintf(stderr, "kernel_launch: unexpected problem (n_in %d out %d ws %zu need %zu)\n", n_in, out_size, ws_size, (size_t)WS_END); grid = -1; return; }
        int dev = 0, cus = 0;
        if (hipGetDevice(&dev) != hipSuccess || hipDeviceGetAttribute(&cus, hipDeviceAttributeMultiprocessorCount, dev) != hipSuccess) { grid = -1; return; }
        if (hipFuncSetAttribute((const void*)trunk_fwd, hipFuncAttributeMaxDynamicSharedMemorySize, LDS_BYTES) != hipSuccess) { fprintf(stderr, "kernel_launch: hipFuncSetAttribute failed\n"); grid = -1; return; }
        int per_cu = 0;
        (void)hipOccupancyMaxActiveBlocksPerMultiprocessor(&per_cu, (const void*)trunk_fwd, 512, LDS_BYTES);
        (void)hipGetLastError();
        grid = cus;
    }
    if (grid < 0) return;
    (void)hipMemsetAsync((char*)d_ws + WS_CTL, 0, CTL_BYTES, stream);
    Args a{};
    for (int i = 0; i < 28; ++i) a.in[i] = (const GAS float*)d_in[i];
    a.out = (GAS float*)d_out; a.ws = (GAS unsigned char*)d_ws; a.G = grid;
    if (N_LAUNCH_MODE == 1) {
        a.ph_lo = 0; a.ph_hi = NPHASE;
        hipLaunchKernelGGL(trunk_fwd, dim3(grid), dim3(512), LDS_BYTES, stream, a);
    } else {
        for (int p = 0; p < NPHASE; ++p) { a.ph_lo = p; a.ph_hi = p + 1; hipLaunchKernelGGL(trunk_fwd, dim3(grid), dim3(512), LDS_BYTES, stream, a); }
#if defined(PROBE_PHASE)
        for (int r = 0; r < PROBE_REPS; ++r) { a.ph_lo = PROBE_PHASE; a.ph_hi = PROBE_PHASE + 1; a.probe = PROBE_SUB; hipLaunchKernelGGL(trunk_fwd, dim3(grid), dim3(512), LDS_BYTES, stream, a); }
#endif
    }
}
```
